# Optimizing an MI355X kernel written in HIP

```python
import math
import jax, jax.numpy as jnp
from jax import lax
import numpy as np

D_MODEL = 2048
BATCH = 1
SEQ = 8192
DEPTH = 4

N_MIXERS = 2
N_ATTN_LAYERS = (DEPTH + 1) // 2
N_LRU_LAYERS = DEPTH // 2

HEAD_DIM = 64
N_HEADS = D_MODEL // HEAD_DIM
N_KV_HEADS = N_HEADS // 8
GROUP = N_HEADS // N_KV_HEADS
WINDOW = 128
BLOCK = 128
Q_W = N_HEADS * HEAD_DIM
KV_W = N_KV_HEADS * HEAD_DIM
ATTN_IN_W = Q_W + 2 * KV_W + Q_W

LRU_W = D_MODEL
LRU_BLOCK_W = 256
N_LRU_BLOCKS = LRU_W // LRU_BLOCK_W
CONV_W = 4
C_RG = 8.0
LRU_IN_W = 2 * LRU_W

NORM_EPS = 1e-6
MASK_VALUE = -1e30

kernel_name = "hybrid_swa_sink_rglru_interleaved"


def rms_norm(x, g):
    x32 = x.astype(jnp.float32)
    y = x32 * lax.rsqrt(jnp.mean(x32 * x32, axis=-1, keepdims=True) + NORM_EPS)
    return (y * g.astype(jnp.float32)).astype(x.dtype)


def sliding_window_attention(h, w_in, w_out, sinks):
    B, S, _ = h.shape
    nb = S // BLOCK
    proj = h @ w_in
    q, k, v, gate = jnp.split(proj, [Q_W, Q_W + KV_W, Q_W + 2 * KV_W], axis=-1)
    q = q.reshape(B, nb, BLOCK, N_KV_HEADS, GROUP, HEAD_DIM)
    k = k.reshape(B, nb, BLOCK, N_KV_HEADS, HEAD_DIM)
    v = v.reshape(B, nb, BLOCK, N_KV_HEADS, HEAD_DIM)
    pad = ((0, 0), (1, 0), (0, 0), (0, 0), (0, 0))
    k_band = jnp.concatenate([jnp.pad(k, pad)[:, :-1], k], axis=2)
    v_band = jnp.concatenate([jnp.pad(v, pad)[:, :-1], v], axis=2)

    scale = 1.0 / math.sqrt(HEAD_DIM)
    scores = jnp.einsum('bnqkgd,bnskd->bnkgqs', q.astype(jnp.float32),
                        k_band.astype(jnp.float32)) * scale
    q_pos = jnp.arange(BLOCK)[:, None] + BLOCK
    k_pos = jnp.arange(2 * BLOCK)[None, :]
    rel = q_pos - k_pos
    in_window = (rel >= 0) & (rel < WINDOW)
    prev_exists = (jnp.arange(nb)[:, None, None] > 0) | (k_pos[None] >= BLOCK)
    mask = (in_window[None] & prev_exists)[:, None, None]
    scores = jnp.where(mask, scores, MASK_VALUE)

    sink = jnp.broadcast_to(
        sinks.astype(jnp.float32).reshape(1, 1, N_KV_HEADS, GROUP, 1, 1),
        scores.shape[:-1] + (1,))
    probs = jax.nn.softmax(jnp.concatenate([scores, sink], axis=-1), axis=-1)[..., :-1]
    out = jnp.einsum('bnkgqs,bnskd->bnqkgd', probs.astype(v.dtype), v_band)
    out = out.reshape(B, S, Q_W)
    return (out * jax.nn.silu(gate)) @ w_out


def _linear_combine(left, right):
    a1, b1 = left
    a2, b2 = right
    return a1 * a2, a2 * b1 + b2


def rglru_block(h, w_in, conv_w, conv_b, w_a, b_a, w_x, b_x, lam, w_out):
    B, S, _ = h.shape
    proj = h @ w_in
    xb, gate = jnp.split(proj, [LRU_W], axis=-1)
    xp = jnp.pad(xb, ((0, 0), (CONV_W - 1, 0), (0, 0)))
    xc = conv_b + sum(conv_w[tap] * xp[:, tap:tap + S] for tap in range(CONV_W))

    xg = xc.reshape(B, S, N_LRU_BLOCKS, LRU_BLOCK_W)
    r = jax.nn.sigmoid(jnp.einsum('bshi,hij->bshj', xg, w_a) + b_a).reshape(B, S, LRU_W)
    i = jax.nn.sigmoid(jnp.einsum('bshi,hij->bshj', xg, w_x) + b_x).reshape(B, S, LRU_W)

    log_a = -C_RG * r.astype(jnp.float32) * jax.nn.softplus(-lam.astype(jnp.float32))
    a = jnp.exp(log_a)
    mult = jnp.sqrt(-jnp.expm1(2.0 * log_a))
    b = mult * (i * xc).astype(jnp.float32)
    _, hs = lax.associative_scan(_linear_combine, (a, b), axis=1)
    y = hs.astype(h.dtype) * jax.nn.silu(gate)
    return y @ w_out


def setup_inputs(seed: int = 0) -> dict:
    key = jax.random.key(seed)
    ks = jax.random.split(key, 16)
    f32 = jnp.float32
    nrm = lambda k, shape, fan_in: jax.random.normal(k, shape, f32) * (fan_in ** -0.5)
    x = jax.random.normal(ks[0], (BATCH, SEQ, D_MODEL), f32)
    norm_pre = 1.0 + 0.05 * jax.random.normal(ks[1], (DEPTH, D_MODEL), f32)
    norm_post = 1.0 + 0.05 * jax.random.normal(ks[2], (DEPTH, D_MODEL), f32)

    attn_w_in = nrm(ks[3], (N_ATTN_LAYERS, D_MODEL, ATTN_IN_W), D_MODEL)
    attn_w_out = nrm(ks[4], (N_ATTN_LAYERS, Q_W, D_MODEL), Q_W)
    attn_sinks = 0.5 * jax.random.normal(ks[5], (N_ATTN_LAYERS, N_HEADS), f32)

    lru_w_in = nrm(ks[6], (N_LRU_LAYERS, D_MODEL, LRU_IN_W), D_MODEL)
    lru_conv_w = nrm(ks[7], (N_LRU_LAYERS, CONV_W, LRU_W), CONV_W)
    lru_conv_b = 0.01 * jax.random.normal(ks[8], (N_LRU_LAYERS, LRU_W), f32)
    lru_w_a = nrm(ks[9], (N_LRU_LAYERS, N_LRU_BLOCKS, LRU_BLOCK_W, LRU_BLOCK_W), LRU_BLOCK_W)
    lru_b_a = 0.01 * jax.random.normal(ks[10], (N_LRU_LAYERS, N_LRU_BLOCKS, LRU_BLOCK_W), f32)
    lru_w_x = nrm(ks[11], (N_LRU_LAYERS, N_LRU_BLOCKS, LRU_BLOCK_W, LRU_BLOCK_W), LRU_BLOCK_W)
    lru_b_x = 0.01 * jax.random.normal(ks[12], (N_LRU_LAYERS, N_LRU_BLOCKS, LRU_BLOCK_W), f32)
    u = jax.random.uniform(ks[13], (N_LRU_LAYERS, LRU_W), f32, 0.9, 0.999)
    a0 = u ** (1.0 / C_RG)
    lru_lambda = jnp.log(a0) - jnp.log1p(-a0)
    lru_w_out = nrm(ks[14], (N_LRU_LAYERS, LRU_W, D_MODEL), LRU_W)
    return {
        "x": x, "norm_pre": norm_pre, "norm_post": norm_post,
        "attn_w_in": attn_w_in, "attn_w_out": attn_w_out, "attn_sinks": attn_sinks,
        "lru_w_in": lru_w_in, "lru_conv_w": lru_conv_w, "lru_conv_b": lru_conv_b,
        "lru_w_a": lru_w_a, "lru_b_a": lru_b_a, "lru_w_x": lru_w_x, "lru_b_x": lru_b_x,
        "lru_lambda": lru_lambda, "lru_w_out": lru_w_out,
    }


def reference(x, norm_pre, norm_post, attn_w_in, attn_w_out, attn_sinks,
              lru_w_in, lru_conv_w, lru_conv_b, lru_w_a, lru_b_a, lru_w_x, lru_b_x,
              lru_lambda, lru_w_out):
    h = x
    for layer in range(DEPTH):
        u = rms_norm(h, norm_pre[layer])
        j = layer // N_MIXERS
        if layer % N_MIXERS == 0:
            y = sliding_window_attention(u, attn_w_in[j], attn_w_out[j], attn_sinks[j])
        else:
            y = rglru_block(u, lru_w_in[j], lru_conv_w[j], lru_conv_b[j], lru_w_a[j],
                            lru_b_a[j], lru_w_x[j], lru_b_x[j], lru_lambda[j], lru_w_out[j])
        h = h + rms_norm(y, norm_post[layer])
    return h
```

```cpp
#include <hip/hip_runtime.h>
#include <hip/hip_cooperative_groups.h>
#include <cstdio>
#include <cstdint>
namespace cg = cooperative_groups;
#ifndef MK_N_LAUNCHES
#define MK_N_LAUNCHES 1
#endif
#ifndef SKIP_ATT
#define SKIP_ATT 0
#endif
#ifndef SKIP_L2
#define SKIP_L2 0
#endif
#ifndef SKIP_L3
#define SKIP_L3 0
#endif
#ifndef SKIP_P0
#define SKIP_P0 0
#endif
#ifndef SKIP_NORM
#define SKIP_NORM 0
#endif
#ifndef SKIP_G1
#define SKIP_G1 0
#endif
namespace pg8 {
#define PG8_LAS __attribute__((address_space(3)))
typedef unsigned short bf16_t;
typedef short bf16x8 __attribute__((ext_vector_type(8)));
typedef float f32x4 __attribute__((ext_vector_type(4)));
typedef unsigned u32x4 __attribute__((ext_vector_type(4)));
constexpr int BM = 256, BK = 64, HALF = 128, HTB = HALF * BK * 2  , STAGE_BYTES = 8 * HTB, NXCD = 8, WGM = 8;

__host__ __device__ __forceinline__ int lds_byte(int r, int c) { const int st = (r >> 4) * 2 + (c >> 5), rr = r & 15, cc = c & 31, ob = rr * 64 + cc * 2; return st * 1024 + (ob ^ (((ob >> 9) & 1) << 5)); }
__host__ __device__ __forceinline__ void stage_rc(int b, int& R, int& C) { const int st = b / 1024, sb = b % 1024, swz = sb ^ (((sb >> 9) & 1) << 5); R = (st >> 1) * 16 + swz / 64; C = (st & 1) * 32 + (swz % 64) / 2; }
__host__ __device__ __forceinline__ int perm32(int rho) { const int n = rho >> 4, i = rho & 15; return 8 * (i >> 2) + 4 * n + (i & 3); }

struct Unit { int pm, pn; };
struct Gemm { const bf16_t* A; const bf16_t* Bt; int M, N, K; };

struct StaticOrder {
    int nM, nN, nwg, G, c;
    __host__ __device__ void init(int M, int N, int G_, int c_) { nM = M / BM; nN = N / BM; nwg = nM * nN; G = G_; c = c_; }
    __host__ __device__ bool next(int i, Unit& u) const {
        const long L = (long)i * G + c; if (L >= nwg) return false;
        int wgid = (int)L; { const int q = nwg / NXCD, r = nwg % NXCD, xcd = wgid % NXCD, off = wgid / NXCD; wgid = (xcd < r ? xcd * (q + 1) : r * (q + 1) + (xcd - r) * q) + off; }
        const int nig = WGM * nN, gid = wgid / nig, fm = gid * WGM, gsz = (nM - fm) < WGM ? (nM - fm) : WGM;
        u.pm = fm + ((wgid % nig) % gsz); u.pn = (wgid % nig) / gsz; return true;
    }
    __device__ __forceinline__ void a_ready(const Unit&) const {}
    __device__ __forceinline__ void done(const Unit&) const {}
};

__device__ __forceinline__ unsigned cvt_pk_bf16(float lo, float hi) { unsigned r; asm volatile("v_cvt_pk_bf16_f32 %0, %1, %2" : "=v"(r) : "v"(lo), "v"(hi)); return r; }
typedef float f32x2 __attribute__((ext_vector_type(2)));
__device__ __forceinline__ float silu_f(float x) { return x * __builtin_amdgcn_rcpf(1.0f + __builtin_amdgcn_exp2f(-1.4426950408889634f * x)); }
struct EpiAny {
    static constexpr bool PERM = true, AFTER_DRAIN = false;
    void* O; int ldc; int q_tiles; float qscale; int silu_from; int f32out;
    __device__ __forceinline__ void operator()(const f32x4 (&acc)[2][2][4][2], const Unit& u, int wr, int wc, int fr, int fq) const {
        const int row0 = u.pm * BM + wr * 64 + fr; const int col0 = u.pn * BM + wc * 32 + 8 * fq;
        if (f32out) {
#pragma unroll
            for (int ai = 0; ai < 2; ++ai)
#pragma unroll
                for (int m = 0; m < 4; ++m) { float* rowp = (float*)O + (size_t)(row0 + ai * HALF + m * 16) * ldc + col0;
#pragma unroll
                    for (int bj = 0; bj < 2; ++bj) { *(f32x4*)(rowp + bj * HALF) = acc[ai][bj][m][0]; *(f32x4*)(rowp + bj * HALF + 4) = acc[ai][bj][m][1]; } }
        } else {
            const float sc = (u.pn < q_tiles) ? qscale : 1.f; const bool act = (u.pn >= silu_from);
#pragma unroll
            for (int ai = 0; ai < 2; ++ai)
#pragma unroll
                for (int m = 0; m < 4; ++m) { bf16_t* rowp = (bf16_t*)O + (size_t)(row0 + ai * HALF + m * 16) * ldc + col0;
#pragma unroll
                    for (int bj = 0; bj < 2; ++bj) { f32x4 v0 = acc[ai][bj][m][0], v1 = acc[ai][bj][m][1];
                        if (act) { v0 = (f32x4){silu_f(v0[0]), silu_f(v0[1]), silu_f(v0[2]), silu_f(v0[3])}; v1 = (f32x4){silu_f(v1[0]), silu_f(v1[1]), silu_f(v1[2]), silu_f(v1[3])}; }
                        v0 = v0 * sc; v1 = v1 * sc; u32x4 w; w.x = cvt_pk_bf16(v0[0], v0[1]); w.y = cvt_pk_bf16(v0[2], v0[3]); w.z = cvt_pk_bf16(v1[0], v1[1]); w.w = cvt_pk_bf16(v1[2], v1[3]);
                        *(u32x4*)(rowp + bj * HALF) = w; } }
        }
    }
};
template <class Epi, class Sched, bool ALIGN_EPI = false, bool SP2 = false>
__device__ __forceinline__ void gemm_phase(PG8_LAS unsigned char* lds, const Gemm g, const Sched& S, const Epi& E) {
    int tid_ = threadIdx.x; asm volatile("" : "+v"(tid_)); const int tid = tid_, wid = __builtin_amdgcn_readfirstlane(tid >> 6), lane = tid & 63, wr = wid >> 2, wc = wid & 3, fr = lane & 15, fq = lane >> 4;
    const int K = g.K, nt = K / BK;
    unsigned voffA[2], voffB[2];
#pragma unroll
    for (int i = 0; i < 2; ++i) { int R, C; stage_rc(tid * 16 + i * 8192, R, C); const int Rb = Epi::PERM ? ((R & ~31) + perm32(R & 31)) : R;
        voffA[i] = (unsigned)(R * K + C) * 2u; voffB[i] = (unsigned)(Rb * K + C) * 2u; }
    const size_t kstep = (size_t)(BK * 2);
    const size_t hstep = (size_t)HALF * K * 2;
    const size_t tstep = 2 * hstep;
    const unsigned ldsw = (unsigned)wid * 1024u;
    const int aoff = lds_byte(wr * 64 + fr, fq * 8), boff = lds_byte(wc * 32 + fr, fq * 8);
#define PG8_SA(b, h) (((b) * 2 + (h)) * HTB)
#define PG8_SB(b, h) ((4 + (b) * 2 + (h)) * HTB)
#define PG8_STAGE(bufoff, gbase, voff) do { _Pragma("unroll") for (int _i = 0; _i < 2; ++_i) \
        __builtin_amdgcn_global_load_lds((const unsigned*)((const char*)(gbase) + (voff)[_i]), (PG8_LAS unsigned*)(lds + (bufoff) + ldsw + _i * 8192), 16, 0, 0); } while (0)
#define PG8_LDA(dst, b, h) do { _Pragma("unroll") for (int m = 0; m < 4; ++m) _Pragma("unroll") for (int k = 0; k < 2; ++k) dst[m][k] = *(const PG8_LAS bf16x8*)(lds + PG8_SA(b, h) + aoff + m * 2048 + k * 1024); } while (0)
#define PG8_LDB(dst, b, h) do { _Pragma("unroll") for (int n = 0; n < 2; ++n) _Pragma("unroll") for (int k = 0; k < 2; ++k) dst[n][k] = *(const PG8_LAS bf16x8*)(lds + PG8_SB(b, h) + boff + n * 2048 + k * 1024); } while (0)
#define PG8_MMA(ai, bj, At, Bt) do { __builtin_amdgcn_s_setprio(1); _Pragma("unroll") for (int m = 0; m < 4; ++m) _Pragma("unroll") for (int n = 0; n < 2; ++n) _Pragma("unroll") for (int k = 0; k < 2; ++k) \
        acc[ai][bj][m][n] = __builtin_amdgcn_mfma_f32_16x16x32_bf16(Bt[n][k], At[m][k], acc[ai][bj][m][n], 0, 0, 0); __builtin_amdgcn_s_setprio(0); } while (0)
#define PG8_WAIT_V(n) asm volatile("s_waitcnt vmcnt(" #n ")" ::: "memory")
#define PG8_WAIT_L(n) asm volatile("s_waitcnt lgkmcnt(" #n ")" ::: "memory")
#define PG8_BAR __builtin_amdgcn_s_barrier()
#define PG8_SCHED __builtin_amdgcn_sched_barrier(0)
    Unit cur, nxt; int ui = 0;
    if (!S.next(0, cur)) return;
    f32x4 acc[2][2][4][2];
#pragma unroll
    for (int a = 0; a < 2; ++a)
#pragma unroll
        for (int b = 0; b < 2; ++b)
#pragma unroll
            for (int m = 0; m < 4; ++m)
#pragma unroll
                for (int n = 0; n < 2; ++n) acc[a][b][m][n] = (f32x4){0.f, 0.f, 0.f, 0.f};
    bf16x8 At[4][2], B0[2][2], B1[2][2];
    const char* cA = (const char*)g.A + (size_t)cur.pm * tstep; const char* cB = (const char*)g.Bt + (size_t)cur.pn * tstep;
    S.a_ready(cur);
    if constexpr (SP2) {
        PG8_STAGE(PG8_SB(0, 0), cB, voffB); PG8_STAGE(PG8_SB(0, 1), cB + hstep, voffB); PG8_STAGE(PG8_SA(0, 0), cA, voffA); PG8_STAGE(PG8_SA(0, 1), cA + hstep, voffA);
        if (wr == 1) PG8_BAR;
        PG8_WAIT_V(2); PG8_BAR;
        PG8_STAGE(PG8_SB(1, 0), cB + kstep, voffB); PG8_STAGE(PG8_SA(1, 0), cA + kstep, voffA); PG8_STAGE(PG8_SB(1, 1), cB + hstep + kstep, voffB);
        PG8_WAIT_V(6); PG8_BAR;
    } else {
        PG8_STAGE(PG8_SB(0, 0), cB, voffB); PG8_STAGE(PG8_SA(0, 0), cA, voffA); PG8_STAGE(PG8_SB(0, 1), cB + hstep, voffB); PG8_STAGE(PG8_SA(0, 1), cA + hstep, voffA);
        if (wr == 1) PG8_BAR;
        PG8_WAIT_V(4); PG8_BAR;
        PG8_STAGE(PG8_SB(1, 0), cB + kstep, voffB); PG8_STAGE(PG8_SA(1, 0), cA + kstep, voffA); PG8_STAGE(PG8_SB(1, 1), cB + hstep + kstep, voffB);
        PG8_WAIT_V(6); PG8_BAR;
    }
    for (;;) {
        const bool has_next = S.next(ui + 1, nxt);
        const char* nA = has_next ? (const char*)g.A + (size_t)nxt.pm * tstep : cA; const char* nB = has_next ? (const char*)g.Bt + (size_t)nxt.pn * tstep : cB;
        for (int t = 0; t < nt; t += 2) {
            const bool last = (t == nt - 2);
            const char* a1 = cA + (size_t)(t + 1) * kstep;
            const char* a2 = last ? nA : cA + (size_t)(t + 2) * kstep; const char* b2 = last ? nB : cB + (size_t)(t + 2) * kstep;
            const char* a3 = a2 + kstep; const char* b3 = b2 + kstep;
            if (last && has_next) S.a_ready(nxt);
            if constexpr (SP2) {
            PG8_LDB(B0, 0, 0); PG8_LDB(B1, 0, 1); PG8_SCHED; PG8_LDA(At, 0, 0); PG8_STAGE(PG8_SA(1, 1), a1 + hstep, voffA);
            PG8_WAIT_V(8); PG8_WAIT_L(0); PG8_BAR; PG8_MMA(0, 0, At, B0); PG8_MMA(0, 1, At, B1); PG8_BAR; PG8_SCHED;
            PG8_LDA(At, 0, 1); PG8_STAGE(PG8_SB(0, 0), b2, voffB); PG8_STAGE(PG8_SB(0, 1), b2 + hstep, voffB); PG8_STAGE(PG8_SA(0, 0), a2, voffA);
            PG8_WAIT_V(8); PG8_WAIT_L(0); PG8_BAR; PG8_MMA(1, 0, At, B0); PG8_MMA(1, 1, At, B1); PG8_BAR; PG8_SCHED;
            PG8_LDB(B0, 1, 0); PG8_LDB(B1, 1, 1); PG8_SCHED; PG8_LDA(At, 1, 0); PG8_STAGE(PG8_SA(0, 1), a2 + hstep, voffA);
            PG8_WAIT_V(8); PG8_WAIT_L(0); PG8_BAR; PG8_MMA(0, 0, At, B0); PG8_MMA(0, 1, At, B1); PG8_BAR; PG8_SCHED;
            PG8_LDA(At, 1, 1); PG8_STAGE(PG8_SB(1, 0), b3, voffB); PG8_STAGE(PG8_SB(1, 1), b3 + hstep, voffB); PG8_STAGE(PG8_SA(1, 0), a3, voffA);
            PG8_WAIT_V(8); PG8_WAIT_L(0); PG8_BAR; PG8_MMA(1, 0, At, B0); PG8_MMA(1, 1, At, B1); PG8_BAR; PG8_SCHED;
            } else {
            PG8_LDB(B0, 0, 0); PG8_SCHED; PG8_LDA(At, 0, 0); PG8_STAGE(PG8_SA(1, 1), a1 + hstep, voffA);
            PG8_WAIT_L(8); PG8_BAR; PG8_WAIT_L(0); PG8_MMA(0, 0, At, B0); PG8_BAR; PG8_SCHED;
            PG8_LDB(B1, 0, 1); PG8_STAGE(PG8_SB(0, 0), b2, voffB);
            PG8_BAR; PG8_WAIT_L(0); PG8_MMA(0, 1, At, B1); PG8_BAR;
            PG8_LDA(At, 0, 1); PG8_STAGE(PG8_SA(0, 0), a2, voffA);
            PG8_BAR; PG8_WAIT_L(0); PG8_MMA(1, 0, At, B0); PG8_BAR; PG8_SCHED;
            PG8_STAGE(PG8_SB(0, 1), b2 + hstep, voffB);
            PG8_WAIT_V(6); PG8_BAR; PG8_MMA(1, 1, At, B1); PG8_BAR;
            PG8_LDB(B0, 1, 0); PG8_SCHED; PG8_LDA(At, 1, 0); PG8_STAGE(PG8_SA(0, 1), a2 + hstep, voffA);
            PG8_WAIT_L(8); PG8_BAR; PG8_WAIT_L(0); PG8_MMA(0, 0, At, B0); PG8_BAR; PG8_SCHED;
            PG8_LDB(B1, 1, 1); PG8_STAGE(PG8_SB(1, 0), b3, voffB);
            PG8_BAR; PG8_WAIT_L(0); PG8_MMA(0, 1, At, B1); PG8_BAR;
            PG8_LDA(At, 1, 1); PG8_STAGE(PG8_SA(1, 0), a3, voffA);
            PG8_BAR; PG8_WAIT_L(0); PG8_MMA(1, 0, At, B0); PG8_BAR; PG8_SCHED;
            PG8_STAGE(PG8_SB(1, 1), b3 + hstep, voffB);
            PG8_WAIT_V(6); PG8_BAR; PG8_MMA(1, 1, At, B1); PG8_BAR;
            }
        }
        if constexpr (ALIGN_EPI) { if (wr == 0) PG8_BAR; }
        if constexpr (!Epi::AFTER_DRAIN) { E(acc, cur, wr, wc, fr, fq); S.done(cur); }
        if (!has_next) break;
#pragma unroll
        for (int a = 0; a < 2; ++a)
#pragma unroll
            for (int b = 0; b < 2; ++b)
#pragma unroll
                for (int m = 0; m < 4; ++m)
#pragma unroll
                    for (int n = 0; n < 2; ++n) acc[a][b][m][n] = (f32x4){0.f, 0.f, 0.f, 0.f};
        cur = nxt; cA = nA; cB = nB; ++ui;
        if constexpr (ALIGN_EPI) { if (wr == 1) PG8_BAR; }
    }
    PG8_WAIT_V(0);
    if constexpr (!ALIGN_EPI) { if (wr == 0) PG8_BAR; }
    PG8_BAR;
    if constexpr (Epi::AFTER_DRAIN) { E.fused(acc, cur, wr, wc, fr, fq, lds, wid, lane); S.done(cur); }
#undef PG8_SA
#undef PG8_SB
#undef PG8_STAGE
#undef PG8_LDA
#undef PG8_LDB
#undef PG8_MMA
#undef PG8_WAIT_V
#undef PG8_WAIT_L
#undef PG8_BAR
#undef PG8_SCHED
}
}

constexpr int S = 8192, DM = 2048, AW = 4608, LW = 4096, NHEAD = 32;
constexpr float EPS = 1e-6f, LOG2E = 1.4426950408889634f;
constexpr float QSCALE = 0.125f * LOG2E;
constexpr size_t MiB = 1u << 20;
constexpr size_t WS_WAIN = 1 * MiB;
constexpr size_t WS_WAOUT = WS_WAIN + 36 * MiB;
constexpr size_t WS_WLIN = WS_WAOUT + 16 * MiB;
constexpr size_t WS_WLOUT = WS_WLIN + 32 * MiB;
constexpr size_t WS_WA = WS_WLOUT + 16 * MiB;
constexpr size_t WS_WX = WS_WA + 2 * MiB;
constexpr size_t WS_UZ = WS_WX + 2 * MiB;
constexpr size_t WS_PROJ = WS_UZ + 32 * MiB;
constexpr size_t WS_Y = WS_PROJ + 72 * MiB;
constexpr size_t WS_SUM = WS_Y + 64 * MiB;
constexpr size_t WS_END = WS_SUM + 1 * MiB;
constexpr int LDS_BYTES = 147456;

#define LAS __attribute__((address_space(3)))
typedef unsigned short bf16;
typedef float f32x4 __attribute__((ext_vector_type(4)));
typedef float f32x2 __attribute__((ext_vector_type(2)));
typedef float f32x16 __attribute__((ext_vector_type(16)));
typedef short bf16x8 __attribute__((ext_vector_type(8)));
typedef unsigned u32x4 __attribute__((ext_vector_type(4)));
typedef unsigned u32x2 __attribute__((ext_vector_type(2)));
typedef __bf16 bf16x2_t __attribute__((ext_vector_type(2)));
__device__ __forceinline__ unsigned pk2(float lo, float hi) { f32x2 v = {lo, hi}; bf16x2_t b = __builtin_convertvector(v, bf16x2_t); return __builtin_bit_cast(unsigned, b); }
__device__ __forceinline__ float bf_lo(unsigned w) { return __uint_as_float(w << 16); }
__device__ __forceinline__ float bf_hi(unsigned w) { return __uint_as_float(w & 0xffff0000u); }
__device__ __forceinline__ float wave_sum(float v) {
#pragma unroll
    for (int o = 1; o < 64; o <<= 1) v += __shfl_xor(v, o);
    return v;
}
__device__ __forceinline__ int crow(int r, int hi) { return (r & 3) + 8 * (r >> 2) + 4 * hi; }
__device__ __forceinline__ float sigmoid_f(float x) { return __builtin_amdgcn_rcpf(1.0f + __builtin_amdgcn_exp2f(-LOG2E * x)); }

__device__ __forceinline__ void transpose_item(const float* W, int K, int N, bf16* WT, LAS float* scr, int item, int lane) {
    const int nblk = N / 32, kb = item / nblk, nb = item % nblk, k0 = 64 * kb, n0 = 32 * nb;
#pragma unroll 8
    for (int i = 0; i < 32; ++i) { const int kk = 2 * i + (lane >> 5); scr[kk * 33 + (lane & 31)] = W[(size_t)(k0 + kk) * N + n0 + (lane & 31)]; }
    asm volatile("s_waitcnt lgkmcnt(0)" ::: "memory");
    const int c = lane & 7;
#pragma unroll
    for (int j = 0; j < 4; ++j) { const int n = (lane >> 3) + 8 * j; const LAS float* s = scr + (8 * c) * 33 + n;
        u32x4 o; o.x = pk2(s[0 * 33], s[1 * 33]); o.y = pk2(s[2 * 33], s[3 * 33]); o.z = pk2(s[4 * 33], s[5 * 33]); o.w = pk2(s[6 * 33], s[7 * 33]);
        *(u32x4*)(WT + (size_t)(n0 + n) * K + k0 + 8 * c) = o; }
    asm volatile("s_waitcnt lgkmcnt(0)" ::: "memory");
}
__device__ __forceinline__ void rms_row_bf16(const float* xrow, const float* g, bf16* orow, int lane) {
    const f32x4* xr = (const f32x4*)xrow + lane; const f32x4* gr = (const f32x4*)g + lane;
    f32x4 v[8]; float ss = 0.f;
#pragma unroll
    for (int j = 0; j < 8; ++j) { v[j] = xr[64 * j]; ss += (v[j].x * v[j].x + v[j].y * v[j].y) + (v[j].z * v[j].z + v[j].w * v[j].w); }
    const float rs = 1.0f / sqrtf(wave_sum(ss) * (1.f / DM) + EPS);
    u32x2* o8 = (u32x2*)orow + lane;
#pragma unroll
    for (int j = 0; j < 8; ++j) { const f32x4 gv = gr[64 * j]; u32x2 w; w.x = pk2(v[j].x * rs * gv.x, v[j].y * rs * gv.y); w.y = pk2(v[j].z * rs * gv.z, v[j].w * rs * gv.w); o8[64 * j] = w; }
}
struct P0Args { const float *x, *npre, *awin, *awout, *lwin, *lwout, *wa, *wx; bf16 *WAIN, *WAOUT, *WLIN, *WLOUT, *WA, *WX, *UZ; };
__device__ __forceinline__ void p0_phase(LAS unsigned char* lds, const P0Args& a, int G, int vb) {
    int tid_ = threadIdx.x; asm volatile("" : "+v"(tid_)); const int tid = tid_, lane = tid & 63, wid = tid >> 6;
    LAS float* scr = (LAS float*)(lds + wid * 16384);
    const int gw = vb * 8 + wid, NGW = G * 8;
    constexpr int I_AIN = (DM / 64) * (AW / 32), I_AOUT = (DM / 64) * (DM / 32), I_LIN = (DM / 64) * (LW / 32), I_LOUT = I_AOUT, I_G = (256 / 64) * (256 / 32);
    constexpr int NITEMS = 2 * (I_AIN + I_AOUT + I_LIN + I_LOUT) + 32 * I_G;
    for (int it = gw; it < NITEMS; it += NGW) {
        int r = it;
        if (r < 2 * I_AIN) { const int j = r / I_AIN; transpose_item(a.awin + (size_t)j * DM * AW, DM, AW, a.WAIN + (size_t)j * DM * AW, scr, r % I_AIN, lane); continue; } r -= 2 * I_AIN;
        if (r < 2 * I_AOUT) { const int j = r / I_AOUT; transpose_item(a.awout + (size_t)j * DM * DM, DM, DM, a.WAOUT + (size_t)j * DM * DM, scr, r % I_AOUT, lane); continue; } r -= 2 * I_AOUT;
        if (r < 2 * I_LIN) { const int j = r / I_LIN; transpose_item(a.lwin + (size_t)j * DM * LW, DM, LW, a.WLIN + (size_t)j * DM * LW, scr, r % I_LIN, lane); continue; } r -= 2 * I_LIN;
        if (r < 2 * I_LOUT) { const int j = r / I_LOUT; transpose_item(a.lwout + (size_t)j * DM * DM, DM, DM, a.WLOUT + (size_t)j * DM * DM, scr, r % I_LOUT, lane); continue; } r -= 2 * I_LOUT;
        if (r < 16 * I_G) { const int j = r / I_G; transpose_item(a.wa + (size_t)j * 65536, 256, 256, a.WA + (size_t)j * 65536, scr, r % I_G, lane); continue; } r -= 16 * I_G;
        { const int j = r / I_G; transpose_item(a.wx + (size_t)j * 65536, 256, 256, a.WX + (size_t)j * 65536, scr, r % I_G, lane); }
    }
    for (int m = gw; m < S; m += NGW) rms_row_bf16(a.x + (size_t)m * DM, a.npre, a.UZ + (size_t)m * DM, lane);
}

__device__ __forceinline__ void norm_phase(const float* y, const float* hin, float* hout, const float* gpost, const float* gpre, bf16* u, int G, int vb) {
    int tid_ = threadIdx.x; asm volatile("" : "+v"(tid_)); const int tid = tid_, lane = tid & 63, wid = tid >> 6;
    const int gw = vb * 8 + wid, NGW = G * 8;
    for (int m = gw; m < S; m += NGW) {
        const f32x4* yr = (const f32x4*)(y + (size_t)m * DM) + lane; const f32x4* hr = (const f32x4*)(hin + (size_t)m * DM) + lane;
        f32x4* ho = (f32x4*)(hout + (size_t)m * DM) + lane;
        f32x4 v[8]; float ss = 0.f;
#pragma unroll
        for (int j = 0; j < 8; ++j) { v[j] = yr[64 * j]; ss += (v[j].x * v[j].x + v[j].y * v[j].y) + (v[j].z * v[j].z + v[j].w * v[j].w); }
        const float rs = 1.0f / sqrtf(wave_sum(ss) * (1.f / DM) + EPS);
        float s2 = 0.f;
#pragma unroll
        for (int j = 0; j < 8; ++j) { const f32x4 g = ((const f32x4*)gpost)[64 * j + lane]; const f32x4 h = hr[64 * j]; v[j] = h + v[j] * rs * g; ho[64 * j] = v[j];
            s2 += (v[j].x * v[j].x + v[j].y * v[j].y) + (v[j].z * v[j].z + v[j].w * v[j].w); }
        if (gpre) {
            const float rs2 = 1.0f / sqrtf(wave_sum(s2) * (1.f / DM) + EPS);
            u32x2* o8 = (u32x2*)(u + (size_t)m * DM) + lane;
#pragma unroll
            for (int j = 0; j < 8; ++j) { const f32x4 g = ((const f32x4*)gpre)[64 * j + lane]; u32x2 w; w.x = pk2(v[j].x * rs2 * g.x, v[j].y * rs2 * g.y); w.y = pk2(v[j].z * rs2 * g.z, v[j].w * rs2 * g.w); o8[64 * j] = w; }
        }
    }
}

constexpr int KP = 144, VP = 520, ATT_V_OFF = 256 * KP;
__device__ __forceinline__ void attn_phase(LAS unsigned char* lds, const bf16* proj, const float* sinks, bf16* z, int G, int vb) {
    int tid_ = threadIdx.x; asm volatile("" : "+v"(tid_)); const int tid = tid_, lane = tid & 63, wid = tid >> 6, l32 = lane & 31, hi = lane >> 5;
    LAS unsigned char* Ks = lds; LAS unsigned char* Vt = lds + ATT_V_OFF;
    for (int u = vb; u < 256; u += G) {
        const int nb = u >> 2, kvh = u & 3;
        __syncthreads();
#pragma unroll
        for (int i = 0; i < 4; ++i) {
            const int p = tid + 512 * i, row = p >> 3, pc = p & 7; const int tok = (nb - 1) * 128 + row;
            u32x4 kv = (u32x4){0u, 0u, 0u, 0u}, vv = (u32x4){0u, 0u, 0u, 0u};
            if (tok >= 0) { const bf16* src = proj + (size_t)tok * AW + 2048 + kvh * 64 + pc * 8; kv = *(const u32x4*)src; vv = *(const u32x4*)(src + 256); }
            *(LAS u32x4*)(Ks + row * KP + pc * 16) = kv;
            LAS unsigned short* vd = (LAS unsigned short*)(Vt + (pc * 8) * VP + row * 2);
            vd[0 * (VP / 2)] = (unsigned short)(vv.x & 0xffffu); vd[1 * (VP / 2)] = (unsigned short)(vv.x >> 16);
            vd[2 * (VP / 2)] = (unsigned short)(vv.y & 0xffffu); vd[3 * (VP / 2)] = (unsigned short)(vv.y >> 16);
            vd[4 * (VP / 2)] = (unsigned short)(vv.z & 0xffffu); vd[5 * (VP / 2)] = (unsigned short)(vv.z >> 16);
            vd[6 * (VP / 2)] = (unsigned short)(vv.w & 0xffffu); vd[7 * (VP / 2)] = (unsigned short)(vv.w >> 16);
        }
        __syncthreads();
        const int h = kvh * 8 + wid;
        const float sink2 = sinks[h] * LOG2E;
#pragma unroll 1
        for (int qt = 0; qt < 4; ++qt) {
            const int qi = 32 * qt + l32; const size_t qrow = (size_t)(nb * 128 + qi);
            bf16x8 qf[4];
#pragma unroll
            for (int ks = 0; ks < 4; ++ks) qf[ks] = *(const bf16x8*)(proj + qrow * AW + h * 64 + ks * 16 + hi * 8);
            f32x16 s[5];
#pragma unroll
            for (int kk = 0; kk < 5; ++kk) {
                f32x16 acc = {};
#pragma unroll
                for (int ks = 0; ks < 4; ++ks) { const bf16x8 kf = *(const LAS bf16x8*)(Ks + (32 * (qt + kk) + l32) * KP + ks * 32 + hi * 16); acc = __builtin_amdgcn_mfma_f32_32x32x16_bf16(kf, qf[ks], acc, 0, 0, 0); }
                s[kk] = acc;
            }
            float mx = sink2;
#pragma unroll
            for (int kk = 0; kk < 5; ++kk)
#pragma unroll
                for (int r = 0; r < 16; ++r) { const int kb = 32 * (qt + kk) + crow(r, hi); const bool valid = (kb > qi) && (kb <= qi + 128) && (nb > 0 || kb >= 128);
                    const float v = valid ? s[kk][r] : -1e30f; s[kk][r] = v; mx = fmaxf(mx, v); }
            mx = fmaxf(mx, __shfl_xor(mx, 32));
            float lsum = 0.f;
#pragma unroll
            for (int kk = 0; kk < 5; ++kk)
#pragma unroll
                for (int r = 0; r < 16; ++r) { const float p = __builtin_amdgcn_exp2f(s[kk][r] - mx); s[kk][r] = p; lsum += p; }
            lsum += __shfl_xor(lsum, 32); lsum += __builtin_amdgcn_exp2f(sink2 - mx);
            f32x16 o[2]; o[0] = (f32x16){}; o[1] = (f32x16){};
#pragma unroll
            for (int kk = 0; kk < 5; ++kk)
#pragma unroll
                for (int j = 0; j < 2; ++j) {
                    u32x4 pw; pw.x = pk2(s[kk][8 * j + 0], s[kk][8 * j + 1]); pw.y = pk2(s[kk][8 * j + 2], s[kk][8 * j + 3]); pw.z = pk2(s[kk][8 * j + 4], s[kk][8 * j + 5]); pw.w = pk2(s[kk][8 * j + 6], s[kk][8 * j + 7]);
                    const bf16x8 pb = __builtin_bit_cast(bf16x8, pw);
#pragma unroll
                    for (int dt = 0; dt < 2; ++dt) { const LAS unsigned char* vp = Vt + (32 * dt + l32) * VP + (32 * (qt + kk) + 16 * j + 4 * hi) * 2;
                        const u32x2 lo = *(const LAS u32x2*)vp, hh = *(const LAS u32x2*)(vp + 16); const u32x4 vw = (u32x4){lo.x, lo.y, hh.x, hh.y};
                        o[dt] = __builtin_amdgcn_mfma_f32_32x32x16_bf16(__builtin_bit_cast(bf16x8, vw), pb, o[dt], 0, 0, 0); }
                }
            const float inv = 1.0f / lsum;
#pragma unroll
            for (int dt = 0; dt < 2; ++dt)
#pragma unroll
                for (int g4 = 0; g4 < 4; ++g4) { const int d0 = 32 * dt + 8 * g4 + 4 * hi;
                    const u32x2 gw = *(const u32x2*)(proj + qrow * AW + 2560 + h * 64 + d0);
                    u32x2 w; w.x = pk2(o[dt][4 * g4 + 0] * inv * bf_lo(gw.x), o[dt][4 * g4 + 1] * inv * bf_hi(gw.x)); w.y = pk2(o[dt][4 * g4 + 2] * inv * bf_lo(gw.y), o[dt][4 * g4 + 3] * inv * bf_hi(gw.y));
                    *(u32x2*)(z + qrow * DM + h * 64 + d0) = w; }
        }
    }
}

constexpr int XP = 528;
struct L2Args { const bf16* proj; const float *convw, *convb, *ba, *bx, *lam; const bf16 *WA, *WX; unsigned* HA; float *SA, *SH; };
__device__ __forceinline__ void lru2_phase(LAS unsigned char* lds, const L2Args& a, int G, int vb) {
    int tid_ = threadIdx.x; asm volatile("" : "+v"(tid_)); const int tid = tid_, lane = tid & 63, wid = tid >> 6, l32 = lane & 31, hi = lane >> 5;
    LAS unsigned char* XC = lds;
    for (int u = vb; u < 512; u += G) {
        const int hb = u & 7, c = u >> 3;
        __syncthreads();
        {
            const int cg4 = tid & 63, tb = tid >> 6; const int ch = hb * 256 + 4 * cg4;
            const f32x4 w0 = *(const f32x4*)(a.convw + 0 * DM + ch), w1 = *(const f32x4*)(a.convw + 1 * DM + ch), w2 = *(const f32x4*)(a.convw + 2 * DM + ch), w3 = *(const f32x4*)(a.convw + 3 * DM + ch);
            const f32x4 cb = *(const f32x4*)(a.convb + ch);
            const int t0 = c * 128 + 16 * tb;
            f32x4 x0, x1, x2;
            { f32x4 xs[3];
#pragma unroll
              for (int i = 0; i < 3; ++i) { const int t = t0 - 3 + i; u32x2 w = (u32x2){0u, 0u}; if (t >= 0) w = *(const u32x2*)(a.proj + (size_t)t * LW + ch); xs[i] = (f32x4){bf_lo(w.x), bf_hi(w.x), bf_lo(w.y), bf_hi(w.y)}; }
              x0 = xs[0]; x1 = xs[1]; x2 = xs[2]; }
#pragma unroll 8
            for (int o = 0; o < 16; ++o) { const u32x2 w = *(const u32x2*)(a.proj + (size_t)(t0 + o) * LW + ch); const f32x4 x3 = (f32x4){bf_lo(w.x), bf_hi(w.x), bf_lo(w.y), bf_hi(w.y)};
                const f32x4 xc = cb + w0 * x0 + w1 * x1 + w2 * x2 + w3 * x3;
                u32x2 ow; ow.x = pk2(xc.x, xc.y); ow.y = pk2(xc.z, xc.w);
                *(LAS u32x2*)(XC + (16 * tb + o) * XP + cg4 * 8) = ow; x0 = x1; x1 = x2; x2 = x3; }
        }
        const int chl = 32 * wid + l32, ch = hb * 256 + chl;
        bf16x8 wa[16], wx[16];
#pragma unroll
        for (int ks = 0; ks < 16; ++ks) { wa[ks] = *(const bf16x8*)(a.WA + ((size_t)hb * 256 + chl) * 256 + ks * 16 + hi * 8); wx[ks] = *(const bf16x8*)(a.WX + ((size_t)hb * 256 + chl) * 256 + ks * 16 + hi * 8); }
        const float bav = a.ba[ch], bxv = a.bx[ch];
        float nl8; { const float nl = -a.lam[ch]; const float sp = (nl > 20.f) ? nl : log1pf(expf(nl)); nl8 = -8.0f * sp; }
        __syncthreads();
        float Crun = 0.f, Qrun = 1.f;
#pragma unroll 1
        for (int tt = 0; tt < 4; ++tt) {
            unsigned obase = (unsigned)((c * 128 + 32 * tt + 4 * hi) * DM + ch); asm volatile("" : "+v"(obase));
            f32x16 pa = {}, px = {};
#pragma unroll
            for (int ks = 0; ks < 16; ++ks) { const bf16x8 af = *(const LAS bf16x8*)(XC + (32 * tt + l32) * XP + ks * 32 + hi * 16);
                pa = __builtin_amdgcn_mfma_f32_32x32x16_bf16(af, wa[ks], pa, 0, 0, 0); px = __builtin_amdgcn_mfma_f32_32x32x16_bf16(af, wx[ks], px, 0, 0, 0); }
            float hl[16], pl[16], P[4], H[4];
#pragma unroll
            for (int g = 0; g < 4; ++g) { float p = 1.f, hh = 0.f;
#pragma unroll
                for (int j = 0; j < 4; ++j) { const int r = 4 * g + j; const int tok = 32 * tt + crow(r, hi);
                    const float rg = sigmoid_f(pa[r] + bav), ig = sigmoid_f(px[r] + bxv);
                    const float la = rg * nl8; const float av = __builtin_amdgcn_exp2f(la * LOG2E);
                    const float x2 = 2.0f * la;
                    const float poly = -x2 * (1.0f + x2 * (0.5f + x2 * (0.16666667f + x2 * (0.041666668f + x2 * (0.0083333338f + x2 * (0.0013888889f + x2 * 0.0001984127f))))));
                    const float em1 = (x2 > -0.3f) ? poly : (1.0f - av * av);
                    const float xcv = __uint_as_float((unsigned)(*(const LAS unsigned short*)(XC + tok * XP + chl * 2)) << 16);
                    const float bv = sqrtf(em1) * ig * xcv;
                    hh = av * hh + bv; p *= av; hl[r] = hh; pl[r] = p; }
                P[g] = p; H[g] = hh; }
            float Po[4], Ho[4];
#pragma unroll
            for (int g = 0; g < 4; ++g) { Po[g] = __shfl_xor(P[g], 32); Ho[g] = __shfl_xor(H[g], 32); }
            float cc = Crun, qq = Qrun;
#pragma unroll
            for (int g = 0; g < 4; ++g) {
                const float P0 = hi ? Po[g] : P[g], H0 = hi ? Ho[g] : H[g], P1 = hi ? P[g] : Po[g], H1 = hi ? H[g] : Ho[g];
                const float c0 = cc, q0 = qq; cc = P0 * cc + H0; qq = qq * P0;
                const float c1 = cc, q1 = qq; cc = P1 * cc + H1; qq = qq * P1;
                const float cm = hi ? c1 : c0, qm = hi ? q1 : q0;
#pragma unroll
                for (int j = 0; j < 4; ++j) { const int r = 4 * g + j; a.HA[obase + (unsigned)((8 * g + j) * DM)] = pk2(hl[r] + pl[r] * cm, pl[r] * qm); }
            }
            Crun = cc; Qrun = qq;
        }
        if (hi == 0) { a.SA[(size_t)c * DM + ch] = Qrun; a.SH[(size_t)c * DM + ch] = Crun; }
    }
}
__device__ __forceinline__ void lru3_phase(const unsigned* HA, const float* SA, const float* SH, const bf16* proj, bf16* z, int G, int vb) {
    int tid_ = threadIdx.x; asm volatile("" : "+v"(tid_)); const int tid = tid_; const int ch = 4 * tid;
    for (int u = vb; u < 512; u += G) {
        const int c = u >> 3, sub = u & 7;
        f32x4 carry = (f32x4){0.f, 0.f, 0.f, 0.f};
        for (int cp = 0; cp < c; ++cp) { const f32x4 A = *(const f32x4*)(SA + (size_t)cp * DM + ch), H = *(const f32x4*)(SH + (size_t)cp * DM + ch); carry = A * carry + H; }
#pragma unroll 4
        for (int i = 0; i < 16; ++i) { const size_t t = (size_t)(c * 128 + sub * 16 + i);
            const u32x4 hw = *(const u32x4*)(HA + t * DM + ch); const u32x2 gw = *(const u32x2*)(proj + t * LW + 2048 + ch);
            const float h0 = (bf_lo(hw.x) + bf_hi(hw.x) * carry.x) * bf_lo(gw.x), h1 = (bf_lo(hw.y) + bf_hi(hw.y) * carry.y) * bf_hi(gw.x);
            const float h2 = (bf_lo(hw.z) + bf_hi(hw.z) * carry.z) * bf_lo(gw.y), h3 = (bf_lo(hw.w) + bf_hi(hw.w) * carry.w) * bf_hi(gw.y);
            u32x2 w; w.x = pk2(h0, h1); w.y = pk2(h2, h3); *(u32x2*)(z + t * DM + ch) = w; }
    }
}

struct Args { const float* in[15]; float* out; unsigned char* ws; int ph_lo, ph_hi; };
constexpr int N_PHASES = 19;
__global__ void __launch_bounds__(512, 2) mk_fwd(Args args) {
    extern __shared__ __attribute__((aligned(16))) unsigned char lds_raw[];
    LAS unsigned char* lds = (LAS unsigned char*)lds_raw;
    cg::grid_group grid = cg::this_grid();
    const int G = gridDim.x, bx = blockIdx.x;
    const int lo = args.ph_lo, hi = args.ph_hi;
    unsigned char* ws = args.ws;
    const float* x = args.in[0]; const float* npre = args.in[1]; const float* npost = args.in[2];
    const float* awin = args.in[3]; const float* awout = args.in[4]; const float* sinks = args.in[5];
    const float* lwin = args.in[6]; const float* convw = args.in[7]; const float* convb = args.in[8];
    const float* wa = args.in[9]; const float* ba = args.in[10]; const float* wx = args.in[11]; const float* bxp = args.in[12];
    const float* lam = args.in[13]; const float* lwout = args.in[14];
    float* out = args.out;
    bf16* WAIN = (bf16*)(ws + WS_WAIN); bf16* WAOUT = (bf16*)(ws + WS_WAOUT); bf16* WLIN = (bf16*)(ws + WS_WLIN); bf16* WLOUT = (bf16*)(ws + WS_WLOUT);
    bf16* WA = (bf16*)(ws + WS_WA); bf16* WX = (bf16*)(ws + WS_WX); bf16* UZ = (bf16*)(ws + WS_UZ); bf16* PROJ = (bf16*)(ws + WS_PROJ);
    float* Y = (float*)(ws + WS_Y); unsigned* HA = (unsigned*)(ws + WS_Y);
    float* SA = (float*)(ws + WS_SUM); float* SH = SA + 64 * DM;
#pragma unroll 1
    for (int ph = lo; ph < hi; ++ph) {
        const int q = ph - 1, j = q / 9, k = q - 9 * j;
        if (ph == 0) { P0Args pa{x, npre, awin, awout, lwin, lwout, wa, wx, WAIN, WAOUT, WLIN, WLOUT, WA, WX, UZ}; if (!SKIP_P0) p0_phase(lds, pa, G, bx); }
        else if (k == 0 || k == 2 || k == 4 || k == 7) {
            const bf16* Bt = (k == 0) ? WAIN + (size_t)j * DM * AW : (k == 2) ? WAOUT + (size_t)j * DM * DM : (k == 4) ? WLIN + (size_t)j * DM * LW : WLOUT + (size_t)j * DM * DM;
            const int N = (k == 0) ? AW : (k == 4) ? LW : DM;
            pg8::Gemm g{UZ, Bt, S, N, DM}; pg8::StaticOrder so; so.init(S, N, G, bx);
            pg8::EpiAny E; E.f32out = (k == 2 || k == 7); E.O = E.f32out ? (void*)Y : (void*)PROJ; E.ldc = N; E.q_tiles = (k == 0) ? 8 : 0; E.qscale = QSCALE; E.silu_from = (k == 0) ? 10 : 8;
            if (!SKIP_G1) pg8::gemm_phase<pg8::EpiAny, pg8::StaticOrder, true, true>(lds, g, so, E);
        }
        else if (k == 1) { if (!SKIP_ATT) attn_phase(lds, PROJ, sinks + j * NHEAD, UZ, G, bx); }
        else if (k == 3 || k == 8) { const int layer = 2 * j + (k == 8);
            if (!SKIP_NORM) norm_phase(Y, layer == 0 ? x : out, out, npost + (size_t)layer * DM, layer < 3 ? npre + (size_t)(layer + 1) * DM : nullptr, UZ, G, bx); }
        else if (k == 5) { L2Args la{PROJ, convw + (size_t)j * 4 * DM, convb + (size_t)j * DM, ba + (size_t)j * DM, bxp + (size_t)j * DM, lam + (size_t)j * DM,
                                     WA + (size_t)j * 8 * 65536, WX + (size_t)j * 8 * 65536, HA, SA, SH}; if (!SKIP_L2) lru2_phase(lds, la, G, bx); }
        else if (!SKIP_L3) lru3_phase(HA, SA, SH, PROJ, UZ, G, bx);
        if (ph + 1 < hi) grid.sync();
    }
}

extern "C" void kernel_launch(void* const* d_in, const int* in_sizes, int n_in, void* d_out, int out_size, void* d_ws, size_t ws_size, hipStream_t stream) {
    static int grid = 0;
    if (grid == 0) {
        if (n_in != 15 || out_size != S * DM || ws_size < WS_END) { fprintf(stderr, "kernel_launch: unexpected shapes (n_in %d out %d ws %zu)\n", n_in, out_size, ws_size); grid = -1; return; }
        int dev = 0, cus = 0, per_cu = 0;
        (void)hipGetDevice(&dev); (void)hipDeviceGetAttribute(&cus, hipDeviceAttributeMultiprocessorCount, dev);
        (void)hipFuncSetAttribute((const void*)mk_fwd, hipFuncAttributeMaxDynamicSharedMemorySize, LDS_BYTES);
        if (hipOccupancyMaxActiveBlocksPerMultiprocessor(&per_cu, (const void*)mk_fwd, 512, LDS_BYTES) != hipSuccess || per_cu < 1) per_cu = 1;
        (void)hipGetLastError();
        grid = cus * per_cu; if (grid <= 0) grid = 256;
    }
    if (grid < 0) return;
    Args a{};
    for (int i = 0; i < 15; ++i) a.in[i] = (const float*)d_in[i];
    a.out = (float*)d_out; a.ws = (unsigned char*)d_ws;
#if MK_N_LAUNCHES == 1
    a.ph_lo = 0; a.ph_hi = N_PHASES;
    void* kargs[] = {&a};
    hipError_t e = hipLaunchCooperativeKernel((const void*)mk_fwd, dim3(grid), dim3(512), kargs, LDS_BYTES, stream);
    if (e != hipSuccess) fprintf(stderr, "cooperative launch failed: %s (grid %d)\n", hipGetErrorString(e), grid);
#else
    for (int ph = 0; ph < N_PHASES; ++ph) { a.ph_lo = ph; a.ph_hi = ph + 1; hipLaunchKernelGGL(mk_fwd, dim3(grid), dim3(512), LDS_BYTES, stream, a); }
#endif
}
```

```cpp
#include <hip/hip_runtime.h>
#include <hip/hip_cooperative_groups.h>
#include <cstdio>
#include <cstdint>
namespace cg = cooperative_groups;
#ifndef MK_N_LAUNCHES
#define MK_N_LAUNCHES 1
#endif
#ifndef SKIP_ATT
#define SKIP_ATT 0
#endif
#ifndef SKIP_L2
#define SKIP_L2 0
#endif
#ifndef SKIP_L3
#define SKIP_L3 0
#endif
#ifndef SKIP_P0
#define SKIP_P0 0
#endif
#ifndef SKIP_NORM
#define SKIP_NORM 0
#endif
#ifndef SKIP_G1
#define SKIP_G1 0
#endif
namespace pg8 {
#define PG8_LAS __attribute__((address_space(3)))
typedef unsigned short bf16_t;
typedef short bf16x8 __attribute__((ext_vector_type(8)));
typedef float f32x4 __attribute__((ext_vector_type(4)));
typedef unsigned u32x4 __attribute__((ext_vector_type(4)));
constexpr int BM = 256, BK = 64, HALF = 128, HTB = HALF * BK * 2  , STAGE_BYTES = 8 * HTB, NXCD = 8, WGM = 8;

__host__ __device__ __forceinline__ int lds_byte(int r, int c) { const int st = (r >> 4) * 2 + (c >> 5), rr = r & 15, cc = c & 31, ob = rr * 64 + cc * 2; return st * 1024 + (ob ^ (((ob >> 9) & 1) << 5)); }
__host__ __device__ __forceinline__ void stage_rc(int b, int& R, int& C) { const int st = b / 1024, sb = b % 1024, swz = sb ^ (((sb >> 9) & 1) << 5); R = (st >> 1) * 16 + swz / 64; C = (st & 1) * 32 + (swz % 64) / 2; }
__host__ __device__ __forceinline__ int perm32(int rho) { const int n = rho >> 4, i = rho & 15; return 8 * (i >> 2) + 4 * n + (i & 3); }

struct Unit { int pm, pn; };
struct Gemm { const bf16_t* A; const bf16_t* Bt; int M, N, K; };

struct StaticOrder {
    int nM, nN, nwg, G, c;
    __host__ __device__ void init(int M, int N, int G_, int c_) { nM = M / BM; nN = N / BM; nwg = nM * nN; G = G_; c = c_; }
    __host__ __device__ bool next(int i, Unit& u) const {
        const long L = (long)i * G + c; if (L >= nwg) return false;
        int wgid = (int)L; { const int q = nwg / NXCD, r = nwg % NXCD, xcd = wgid % NXCD, off = wgid / NXCD; wgid = (xcd < r ? xcd * (q + 1) : r * (q + 1) + (xcd - r) * q) + off; }
        const int nig = WGM * nN, gid = wgid / nig, fm = gid * WGM, gsz = (nM - fm) < WGM ? (nM - fm) : WGM;
        u.pm = fm + ((wgid % nig) % gsz); u.pn = (wgid % nig) / gsz; return true;
    }
    __device__ __forceinline__ void a_ready(const Unit&) const {}
    __device__ __forceinline__ void done(const Unit&) const {}
};

__device__ __forceinline__ unsigned cvt_pk_bf16(float lo, float hi) { unsigned r; asm volatile("v_cvt_pk_bf16_f32 %0, %1, %2" : "=v"(r) : "v"(lo), "v"(hi)); return r; }
typedef float f32x2 __attribute__((ext_vector_type(2)));
__device__ __forceinline__ float silu_f(float x) { return x * __builtin_amdgcn_rcpf(1.0f + __builtin_amdgcn_exp2f(-1.4426950408889634f * x)); }
struct EpiAny {
    static constexpr bool PERM = true, AFTER_DRAIN = false;
    void* O; int ldc; int q_tiles; float qscale; int silu_from; int f32out;
    __device__ __forceinline__ void operator()(const f32x4 (&acc)[2][2][4][2], const Unit& u, int wr, int wc, int fr, int fq) const {
        const int row0 = u.pm * BM + wr * 64 + fr; const int col0 = u.pn * BM + wc * 32 + 8 * fq;
        if (f32out) {
#pragma unroll
            for (int ai = 0; ai < 2; ++ai)
#pragma unroll
                for (int m = 0; m < 4; ++m) { float* rowp = (float*)O + (size_t)(row0 + ai * HALF + m * 16) * ldc + col0;
#pragma unroll
                    for (int bj = 0; bj < 2; ++bj) { *(f32x4*)(rowp + bj * HALF) = acc[ai][bj][m][0]; *(f32x4*)(rowp + bj * HALF + 4) = acc[ai][bj][m][1]; } }
        } else {
            const float sc = (u.pn < q_tiles) ? qscale : 1.f; const bool act = (u.pn >= silu_from);
#pragma unroll
            for (int ai = 0; ai < 2; ++ai)
#pragma unroll
                for (int m = 0; m < 4; ++m) { bf16_t* rowp = (bf16_t*)O + (size_t)(row0 + ai * HALF + m * 16) * ldc + col0;
#pragma unroll
                    for (int bj = 0; bj < 2; ++bj) { f32x4 v0 = acc[ai][bj][m][0], v1 = acc[ai][bj][m][1];
                        if (act) { v0 = (f32x4){silu_f(v0[0]), silu_f(v0[1]), silu_f(v0[2]), silu_f(v0[3])}; v1 = (f32x4){silu_f(v1[0]), silu_f(v1[1]), silu_f(v1[2]), silu_f(v1[3])}; }
                        v0 = v0 * sc; v1 = v1 * sc; u32x4 w; w.x = cvt_pk_bf16(v0[0], v0[1]); w.y = cvt_pk_bf16(v0[2], v0[3]); w.z = cvt_pk_bf16(v1[0], v1[1]); w.w = cvt_pk_bf16(v1[2], v1[3]);
                        *(u32x4*)(rowp + bj * HALF) = w; } }
        }
    }
};
template <class Epi, class Sched, bool ALIGN_EPI = false, bool SP2 = false>
__device__ __forceinline__ void gemm_phase(PG8_LAS unsigned char* lds, const Gemm g, const Sched& S, const Epi& E) {
    int tid_ = threadIdx.x; asm volatile("" : "+v"(tid_)); const int tid = tid_, wid = __builtin_amdgcn_readfirstlane(tid >> 6), lane = tid & 63, wr = wid >> 2, wc = wid & 3, fr = lane & 15, fq = lane >> 4;
    const int K = g.K, nt = K / BK;
    unsigned voffA[2], voffB[2];
#pragma unroll
    for (int i = 0; i < 2; ++i) { int R, C; stage_rc(tid * 16 + i * 8192, R, C); const int Rb = Epi::PERM ? ((R & ~31) + perm32(R & 31)) : R;
        voffA[i] = (unsigned)(R * K + C) * 2u; voffB[i] = (unsigned)(Rb * K + C) * 2u; }
    const size_t kstep = (size_t)(BK * 2);
    const size_t hstep = (size_t)HALF * K * 2;
    const size_t tstep = 2 * hstep;
    const unsigned ldsw = (unsigned)wid * 1024u;
    const int aoff = lds_byte(wr * 64 + fr, fq * 8), boff = lds_byte(wc * 32 + fr, fq * 8);
#define PG8_SA(b, h) (((b) * 2 + (h)) * HTB)
#define PG8_SB(b, h) ((4 + (b) * 2 + (h)) * HTB)
#define PG8_STAGE(bufoff, gbase, voff) do { _Pragma("unroll") for (int _i = 0; _i < 2; ++_i) \
        __builtin_amdgcn_global_load_lds((const unsigned*)((const char*)(gbase) + (voff)[_i]), (PG8_LAS unsigned*)(lds + (bufoff) + ldsw + _i * 8192), 16, 0, 0); } while (0)
#define PG8_LDA(dst, b, h) do { _Pragma("unroll") for (int m = 0; m < 4; ++m) _Pragma("unroll") for (int k = 0; k < 2; ++k) dst[m][k] = *(const PG8_LAS bf16x8*)(lds + PG8_SA(b, h) + aoff + m * 2048 + k * 1024); } while (0)
#define PG8_LDB(dst, b, h) do { _Pragma("unroll") for (int n = 0; n < 2; ++n) _Pragma("unroll") for (int k = 0; k < 2; ++k) dst[n][k] = *(const PG8_LAS bf16x8*)(lds + PG8_SB(b, h) + boff + n * 2048 + k * 1024); } while (0)
#define PG8_MMA(ai, bj, At, Bt) do { __builtin_amdgcn_s_setprio(1); _Pragma("unroll") for (int m = 0; m < 4; ++m) _Pragma("unroll") for (int n = 0; n < 2; ++n) _Pragma("unroll") for (int k = 0; k < 2; ++k) \
        acc[ai][bj][m][n] = __builtin_amdgcn_mfma_f32_16x16x32_bf16(Bt[n][k], At[m][k], acc[ai][bj][m][n], 0, 0, 0); __builtin_amdgcn_s_setprio(0); } while (0)
#define PG8_WAIT_V(n) asm volatile("s_waitcnt vmcnt(" #n ")" ::: "memory")
#define PG8_WAIT_L(n) asm volatile("s_waitcnt lgkmcnt(" #n ")" ::: "memory")
#define PG8_BAR __builtin_amdgcn_s_barrier()
#define PG8_SCHED __builtin_amdgcn_sched_barrier(0)
    Unit cur, nxt; int ui = 0;
    if (!S.next(0, cur)) return;
    f32x4 acc[2][2][4][2];
#pragma unroll
    for (int a = 0; a < 2; ++a)
#pragma unroll
        for (int b = 0; b < 2; ++b)
#pragma unroll
            for (int m = 0; m < 4; ++m)
#pragma unroll
                for (int n = 0; n < 2; ++n) acc[a][b][m][n] = (f32x4){0.f, 0.f, 0.f, 0.f};
    bf16x8 At[4][2], B0[2][2], B1[2][2];
    const char* cA = (const char*)g.A + (size_t)cur.pm * tstep; const char* cB = (const char*)g.Bt + (size_t)cur.pn * tstep;
    S.a_ready(cur);
    if constexpr (SP2) {
        PG8_STAGE(PG8_SB(0, 0), cB, voffB); PG8_STAGE(PG8_SB(0, 1), cB + hstep, voffB); PG8_STAGE(PG8_SA(0, 0), cA, voffA); PG8_STAGE(PG8_SA(0, 1), cA + hstep, voffA);
        if (wr == 1) PG8_BAR;
        PG8_WAIT_V(2); PG8_BAR;
        PG8_STAGE(PG8_SB(1, 0), cB + kstep, voffB); PG8_STAGE(PG8_SA(1, 0), cA + kstep, voffA); PG8_STAGE(PG8_SB(1, 1), cB + hstep + kstep, voffB);
        PG8_WAIT_V(6); PG8_BAR;
    } else {
        PG8_STAGE(PG8_SB(0, 0), cB, voffB); PG8_STAGE(PG8_SA(0, 0), cA, voffA); PG8_STAGE(PG8_SB(0, 1), cB + hstep, voffB); PG8_STAGE(PG8_SA(0, 1), cA + hstep, voffA);
        if (wr == 1) PG8_BAR;
        PG8_WAIT_V(4); PG8_BAR;
        PG8_STAGE(PG8_SB(1, 0), cB + kstep, voffB); PG8_STAGE(PG8_SA(1, 0), cA + kstep, voffA); PG8_STAGE(PG8_SB(1, 1), cB + hstep + kstep, voffB);
        PG8_WAIT_V(6); PG8_BAR;
    }
    for (;;) {
        const bool has_next = S.next(ui + 1, nxt);
        const char* nA = has_next ? (const char*)g.A + (size_t)nxt.pm * tstep : cA; const char* nB = has_next ? (const char*)g.Bt + (size_t)nxt.pn * tstep : cB;
        for (int t = 0; t < nt; t += 2) {
            const bool last = (t == nt - 2);
            const char* a1 = cA + (size_t)(t + 1) * kstep;
            const char* a2 = last ? nA : cA + (size_t)(t + 2) * kstep; const char* b2 = last ? nB : cB + (size_t)(t + 2) * kstep;
            const char* a3 = a2 + kstep; const char* b3 = b2 + kstep;
            if (last && has_next) S.a_ready(nxt);
            if constexpr (SP2) {
            PG8_LDB(B0, 0, 0); PG8_LDB(B1, 0, 1); PG8_SCHED; PG8_LDA(At, 0, 0); PG8_STAGE(PG8_SA(1, 1), a1 + hstep, voffA);
            PG8_WAIT_V(8); PG8_WAIT_L(0); PG8_BAR; PG8_MMA(0, 0, At, B0); PG8_MMA(0, 1, At, B1); PG8_BAR; PG8_SCHED;
            PG8_LDA(At, 0, 1); PG8_STAGE(PG8_SB(0, 0), b2, voffB); PG8_STAGE(PG8_SB(0, 1), b2 + hstep, voffB); PG8_STAGE(PG8_SA(0, 0), a2, voffA);
            PG8_WAIT_V(8); PG8_WAIT_L(0); PG8_BAR; PG8_MMA(1, 0, At, B0); PG8_MMA(1, 1, At, B1); PG8_BAR; PG8_SCHED;
            PG8_LDB(B0, 1, 0); PG8_LDB(B1, 1, 1); PG8_SCHED; PG8_LDA(At, 1, 0); PG8_STAGE(PG8_SA(0, 1), a2 + hstep, voffA);
            PG8_WAIT_V(8); PG8_WAIT_L(0); PG8_BAR; PG8_MMA(0, 0, At, B0); PG8_MMA(0, 1, At, B1); PG8_BAR; PG8_SCHED;
            PG8_LDA(At, 1, 1); PG8_STAGE(PG8_SB(1, 0), b3, voffB); PG8_STAGE(PG8_SB(1, 1), b3 + hstep, voffB); PG8_STAGE(PG8_SA(1, 0), a3, voffA);
            PG8_WAIT_V(8); PG8_WAIT_L(0); PG8_BAR; PG8_MMA(1, 0, At, B0); PG8_MMA(1, 1, At, B1); PG8_BAR; PG8_SCHED;
            } else {
            PG8_LDB(B0, 0, 0); PG8_SCHED; PG8_LDA(At, 0, 0); PG8_STAGE(PG8_SA(1, 1), a1 + hstep, voffA);
            PG8_WAIT_L(8); PG8_BAR; PG8_WAIT_L(0); PG8_MMA(0, 0, At, B0); PG8_BAR; PG8_SCHED;
            PG8_LDB(B1, 0, 1); PG8_STAGE(PG8_SB(0, 0), b2, voffB);
            PG8_BAR; PG8_WAIT_L(0); PG8_MMA(0, 1, At, B1); PG8_BAR;
            PG8_LDA(At, 0, 1); PG8_STAGE(PG8_SA(0, 0), a2, voffA);
            PG8_BAR; PG8_WAIT_L(0); PG8_MMA(1, 0, At, B0); PG8_BAR; PG8_SCHED;
            PG8_STAGE(PG8_SB(0, 1), b2 + hstep, voffB);
            PG8_WAIT_V(6); PG8_BAR; PG8_MMA(1, 1, At, B1); PG8_BAR;
            PG8_LDB(B0, 1, 0); PG8_SCHED; PG8_LDA(At, 1, 0); PG8_STAGE(PG8_SA(0, 1), a2 + hstep, voffA);
            PG8_WAIT_L(8); PG8_BAR; PG8_WAIT_L(0); PG8_MMA(0, 0, At, B0); PG8_BAR; PG8_SCHED;
            PG8_LDB(B1, 1, 1); PG8_STAGE(PG8_SB(1, 0), b3, voffB);
            PG8_BAR; PG8_WAIT_L(0); PG8_MMA(0, 1, At, B1); PG8_BAR;
            PG8_LDA(At, 1, 1); PG8_STAGE(PG8_SA(1, 0), a3, voffA);
            PG8_BAR; PG8_WAIT_L(0); PG8_MMA(1, 0, At, B0); PG8_BAR; PG8_SCHED;
            PG8_STAGE(PG8_SB(1, 1), b3 + hstep, voffB);
            PG8_WAIT_V(6); PG8_BAR; PG8_MMA(1, 1, At, B1); PG8_BAR;
            }
        }
        if constexpr (ALIGN_EPI) { if (wr == 0) PG8_BAR; }
        if constexpr (!Epi::AFTER_DRAIN) { E(acc, cur, wr, wc, fr, fq); S.done(cur); }
        if (!has_next) break;
#pragma unroll
        for (int a = 0; a < 2; ++a)
#pragma unroll
            for (int b = 0; b < 2; ++b)
#pragma unroll
                for (int m = 0; m < 4; ++m)
#pragma unroll
                    for (int n = 0; n < 2; ++n) acc[a][b][m][n] = (f32x4){0.f, 0.f, 0.f, 0.f};
        cur = nxt; cA = nA; cB = nB; ++ui;
        if constexpr (ALIGN_EPI) { if (wr == 1) PG8_BAR; }
    }
    PG8_WAIT_V(0);
    if constexpr (!ALIGN_EPI) { if (wr == 0) PG8_BAR; }
    PG8_BAR;
    if constexpr (Epi::AFTER_DRAIN) { E.fused(acc, cur, wr, wc, fr, fq, lds, wid, lane); S.done(cur); }
#undef PG8_SA
#undef PG8_SB
#undef PG8_STAGE
#undef PG8_LDA
#undef PG8_LDB
#undef PG8_MMA
#undef PG8_WAIT_V
#undef PG8_WAIT_L
#undef PG8_BAR
#undef PG8_SCHED
}
}

constexpr int S = 8192, DM = 2048, AW = 4608, LW = 4096, NHEAD = 32;
constexpr float EPS = 1e-6f, LOG2E = 1.4426950408889634f;
constexpr float QSCALE = 0.125f * LOG2E;
constexpr size_t MiB = 1u << 20;
constexpr size_t WS_WAIN = 1 * MiB;
constexpr size_t WS_WAOUT = WS_WAIN + 36 * MiB;
constexpr size_t WS_WLIN = WS_WAOUT + 16 * MiB;
constexpr size_t WS_WLOUT = WS_WLIN + 32 * MiB;
constexpr size_t WS_WA = WS_WLOUT + 16 * MiB;
constexpr size_t WS_WX = WS_WA + 2 * MiB;
constexpr size_t WS_UZ = WS_WX + 2 * MiB;
constexpr size_t WS_PROJ = WS_UZ + 32 * MiB;
constexpr size_t WS_Y = WS_PROJ + 72 * MiB;
constexpr size_t WS_SUM = WS_Y + 64 * MiB;
constexpr size_t WS_END = WS_SUM + 1 * MiB;
constexpr int LDS_BYTES = 147456, LDSCTL_OFF = 131072;
constexpr size_t WS_CTL = 0, CTL_ZERO_BYTES = 65536;

#define LAS __attribute__((address_space(3)))
typedef unsigned short bf16;
typedef float f32x4 __attribute__((ext_vector_type(4)));
typedef float f32x2 __attribute__((ext_vector_type(2)));
typedef float f32x16 __attribute__((ext_vector_type(16)));
typedef short bf16x8 __attribute__((ext_vector_type(8)));
typedef unsigned u32x4 __attribute__((ext_vector_type(4)));
typedef unsigned u32x2 __attribute__((ext_vector_type(2)));
typedef __bf16 bf16x2_t __attribute__((ext_vector_type(2)));
__device__ __forceinline__ unsigned pk2(float lo, float hi) { f32x2 v = {lo, hi}; bf16x2_t b = __builtin_convertvector(v, bf16x2_t); return __builtin_bit_cast(unsigned, b); }
__device__ __forceinline__ float bf_lo(unsigned w) { return __uint_as_float(w << 16); }
__device__ __forceinline__ float bf_hi(unsigned w) { return __uint_as_float(w & 0xffff0000u); }
__device__ __forceinline__ float wave_sum(float v) {
#pragma unroll
    for (int o = 1; o < 64; o <<= 1) v += __shfl_xor(v, o);
    return v;
}
__device__ __forceinline__ int crow(int r, int hi) { return (r & 3) + 8 * (r >> 2) + 4 * hi; }
__device__ __forceinline__ float sigmoid_f(float x) { return __builtin_amdgcn_rcpf(1.0f + __builtin_amdgcn_exp2f(-LOG2E * x)); }

__device__ __forceinline__ void transpose_item(const float* W, int K, int N, bf16* WT, LAS float* scr, int item, int lane) {
    const int nblk = N / 32, kb = item / nblk, nb = item % nblk, k0 = 64 * kb, n0 = 32 * nb;
#pragma unroll 8
    for (int i = 0; i < 32; ++i) { const int kk = 2 * i + (lane >> 5); scr[kk * 33 + (lane & 31)] = W[(size_t)(k0 + kk) * N + n0 + (lane & 31)]; }
    asm volatile("s_waitcnt lgkmcnt(0)" ::: "memory");
    const int c = lane & 7;
#pragma unroll
    for (int j = 0; j < 4; ++j) { const int n = (lane >> 3) + 8 * j; const LAS float* s = scr + (8 * c) * 33 + n;
        u32x4 o; o.x = pk2(s[0 * 33], s[1 * 33]); o.y = pk2(s[2 * 33], s[3 * 33]); o.z = pk2(s[4 * 33], s[5 * 33]); o.w = pk2(s[6 * 33], s[7 * 33]);
        *(u32x4*)(WT + (size_t)(n0 + n) * K + k0 + 8 * c) = o; }
    asm volatile("s_waitcnt lgkmcnt(0)" ::: "memory");
}
__device__ __forceinline__ void rms_row_bf16(const float* xrow, const float* g, bf16* orow, int lane) {
    const f32x4* xr = (const f32x4*)xrow + lane; const f32x4* gr = (const f32x4*)g + lane;
    f32x4 v[8]; float ss = 0.f;
#pragma unroll
    for (int j = 0; j < 8; ++j) { v[j] = xr[64 * j]; ss += (v[j].x * v[j].x + v[j].y * v[j].y) + (v[j].z * v[j].z + v[j].w * v[j].w); }
    const float rs = 1.0f / sqrtf(wave_sum(ss) * (1.f / DM) + EPS);
    u32x2* o8 = (u32x2*)orow + lane;
#pragma unroll
    for (int j = 0; j < 8; ++j) { const f32x4 gv = gr[64 * j]; u32x2 w; w.x = pk2(v[j].x * rs * gv.x, v[j].y * rs * gv.y); w.y = pk2(v[j].z * rs * gv.z, v[j].w * rs * gv.w); o8[64 * j] = w; }
}
struct P0Args { const float *x, *npre, *awin, *awout, *lwin, *lwout, *wa, *wx; bf16 *WAIN, *WAOUT, *WLIN, *WLOUT, *WA, *WX, *UZ; };
__device__ __forceinline__ void p0_phase(LAS unsigned char* lds, const P0Args& a, int G, int vb) {
    int tid_ = threadIdx.x; asm volatile("" : "+v"(tid_)); const int tid = tid_, lane = tid & 63, wid = tid >> 6;
    LAS float* scr = (LAS float*)(lds + wid * 16384);
    const int gw = vb * 8 + wid, NGW = G * 8;
    constexpr int I_AIN = (DM / 64) * (AW / 32), I_AOUT = (DM / 64) * (DM / 32), I_LIN = (DM / 64) * (LW / 32), I_LOUT = I_AOUT, I_G = (256 / 64) * (256 / 32);
    constexpr int NITEMS = 2 * (I_AIN + I_AOUT + I_LIN + I_LOUT) + 32 * I_G;
    for (int it = gw; it < NITEMS; it += NGW) {
        int r = it;
        if (r < 2 * I_AIN) { const int j = r / I_AIN; transpose_item(a.awin + (size_t)j * DM * AW, DM, AW, a.WAIN + (size_t)j * DM * AW, scr, r % I_AIN, lane); continue; } r -= 2 * I_AIN;
        if (r < 2 * I_AOUT) { const int j = r / I_AOUT; transpose_item(a.awout + (size_t)j * DM * DM, DM, DM, a.WAOUT + (size_t)j * DM * DM, scr, r % I_AOUT, lane); continue; } r -= 2 * I_AOUT;
        if (r < 2 * I_LIN) { const int j = r / I_LIN; transpose_item(a.lwin + (size_t)j * DM * LW, DM, LW, a.WLIN + (size_t)j * DM * LW, scr, r % I_LIN, lane); continue; } r -= 2 * I_LIN;
        if (r < 2 * I_LOUT) { const int j = r / I_LOUT; transpose_item(a.lwout + (size_t)j * DM * DM, DM, DM, a.WLOUT + (size_t)j * DM * DM, scr, r % I_LOUT, lane); continue; } r -= 2 * I_LOUT;
        if (r < 16 * I_G) { const int j = r / I_G; transpose_item(a.wa + (size_t)j * 65536, 256, 256, a.WA + (size_t)j * 65536, scr, r % I_G, lane); continue; } r -= 16 * I_G;
        { const int j = r / I_G; transpose_item(a.wx + (size_t)j * 65536, 256, 256, a.WX + (size_t)j * 65536, scr, r % I_G, lane); }
    }
    for (int m = gw; m < S; m += NGW) rms_row_bf16(a.x + (size_t)m * DM, a.npre, a.UZ + (size_t)m * DM, lane);
}

__device__ __forceinline__ void norm_phase(const float* y, const float* hin, float* hout, const float* gpost, const float* gpre, bf16* u, int G, int vb) {
    int tid_ = threadIdx.x; asm volatile("" : "+v"(tid_)); const int tid = tid_, lane = tid & 63, wid = tid >> 6;
    const int gw = vb * 8 + wid, NGW = G * 8;
    for (int m = gw; m < S; m += NGW) {
        const f32x4* yr = (const f32x4*)(y + (size_t)m * DM) + lane; const f32x4* hr = (const f32x4*)(hin + (size_t)m * DM) + lane;
        f32x4* ho = (f32x4*)(hout + (size_t)m * DM) + lane;
        f32x4 v[8]; float ss = 0.f;
#pragma unroll
        for (int j = 0; j < 8; ++j) { v[j] = yr[64 * j]; ss += (v[j].x * v[j].x + v[j].y * v[j].y) + (v[j].z * v[j].z + v[j].w * v[j].w); }
        const float rs = 1.0f / sqrtf(wave_sum(ss) * (1.f / DM) + EPS);
        float s2 = 0.f;
#pragma unroll
        for (int j = 0; j < 8; ++j) { const f32x4 g = ((const f32x4*)gpost)[64 * j + lane]; const f32x4 h = hr[64 * j]; v[j] = h + v[j] * rs * g; ho[64 * j] = v[j];
            s2 += (v[j].x * v[j].x + v[j].y * v[j].y) + (v[j].z * v[j].z + v[j].w * v[j].w); }
        if (gpre) {
            const float rs2 = 1.0f / sqrtf(wave_sum(s2) * (1.f / DM) + EPS);
            u32x2* o8 = (u32x2*)(u + (size_t)m * DM) + lane;
#pragma unroll
            for (int j = 0; j < 8; ++j) { const f32x4 g = ((const f32x4*)gpre)[64 * j + lane]; u32x2 w; w.x = pk2(v[j].x * rs2 * g.x, v[j].y * rs2 * g.y); w.y = pk2(v[j].z * rs2 * g.z, v[j].w * rs2 * g.w); o8[64 * j] = w; }
        }
    }
}

constexpr int KP = 144, VP = 520, ATT_V_OFF = 256 * KP;
__device__ __forceinline__ void attn_phase(LAS unsigned char* lds, const bf16* proj, const float* sinks, bf16* z, int G, int vb) {
    int tid_ = threadIdx.x; asm volatile("" : "+v"(tid_)); const int tid = tid_, lane = tid & 63, wid = tid >> 6, l32 = lane & 31, hi = lane >> 5;
    LAS unsigned char* Ks = lds; LAS unsigned char* Vt = lds + ATT_V_OFF;
    for (int u = vb; u < 256; u += G) {
        const int nb = u >> 2, kvh = u & 3;
        __syncthreads();
#pragma unroll
        for (int i = 0; i < 4; ++i) {
            const int p = tid + 512 * i, row = p >> 3, pc = p & 7; const int tok = (nb - 1) * 128 + row;
            u32x4 kv = (u32x4){0u, 0u, 0u, 0u}, vv = (u32x4){0u, 0u, 0u, 0u};
            if (tok >= 0) { const bf16* src = proj + (size_t)tok * AW + 2048 + kvh * 64 + pc * 8; kv = *(const u32x4*)src; vv = *(const u32x4*)(src + 256); }
            *(LAS u32x4*)(Ks + row * KP + pc * 16) = kv;
            LAS unsigned short* vd = (LAS unsigned short*)(Vt + (pc * 8) * VP + row * 2);
            vd[0 * (VP / 2)] = (unsigned short)(vv.x & 0xffffu); vd[1 * (VP / 2)] = (unsigned short)(vv.x >> 16);
            vd[2 * (VP / 2)] = (unsigned short)(vv.y & 0xffffu); vd[3 * (VP / 2)] = (unsigned short)(vv.y >> 16);
            vd[4 * (VP / 2)] = (unsigned short)(vv.z & 0xffffu); vd[5 * (VP / 2)] = (unsigned short)(vv.z >> 16);
            vd[6 * (VP / 2)] = (unsigned short)(vv.w & 0xffffu); vd[7 * (VP / 2)] = (unsigned short)(vv.w >> 16);
        }
        __syncthreads();
        const int h = kvh * 8 + wid;
        const float sink2 = sinks[h] * LOG2E;
#pragma unroll 1
        for (int qt = 0; qt < 4; ++qt) {
            const int qi = 32 * qt + l32; const size_t qrow = (size_t)(nb * 128 + qi);
            bf16x8 qf[4];
#pragma unroll
            for (int ks = 0; ks < 4; ++ks) qf[ks] = *(const bf16x8*)(proj + qrow * AW + h * 64 + ks * 16 + hi * 8);
            f32x16 s[5];
#pragma unroll
            for (int kk = 0; kk < 5; ++kk) {
                f32x16 acc = {};
#pragma unroll
                for (int ks = 0; ks < 4; ++ks) { const bf16x8 kf = *(const LAS bf16x8*)(Ks + (32 * (qt + kk) + l32) * KP + ks * 32 + hi * 16); acc = __builtin_amdgcn_mfma_f32_32x32x16_bf16(kf, qf[ks], acc, 0, 0, 0); }
                s[kk] = acc;
            }
            float mx = sink2;
#pragma unroll
            for (int kk = 0; kk < 5; ++kk)
#pragma unroll
                for (int r = 0; r < 16; ++r) { const int kb = 32 * (qt + kk) + crow(r, hi); const bool valid = (kb > qi) && (kb <= qi + 128) && (nb > 0 || kb >= 128);
                    const float v = valid ? s[kk][r] : -1e30f; s[kk][r] = v; mx = fmaxf(mx, v); }
            mx = fmaxf(mx, __shfl_xor(mx, 32));
            float lsum = 0.f;
#pragma unroll
            for (int kk = 0; kk < 5; ++kk)
#pragma unroll
                for (int r = 0; r < 16; ++r) { const float p = __builtin_amdgcn_exp2f(s[kk][r] - mx); s[kk][r] = p; lsum += p; }
            lsum += __shfl_xor(lsum, 32); lsum += __builtin_amdgcn_exp2f(sink2 - mx);
            f32x16 o[2]; o[0] = (f32x16){}; o[1] = (f32x16){};
#pragma unroll
            for (int kk = 0; kk < 5; ++kk)
#pragma unroll
                for (int j = 0; j < 2; ++j) {
                    u32x4 pw; pw.x = pk2(s[kk][8 * j + 0], s[kk][8 * j + 1]); pw.y = pk2(s[kk][8 * j + 2], s[kk][8 * j + 3]); pw.z = pk2(s[kk][8 * j + 4], s[kk][8 * j + 5]); pw.w = pk2(s[kk][8 * j + 6], s[kk][8 * j + 7]);
                    const bf16x8 pb = __builtin_bit_cast(bf16x8, pw);
#pragma unroll
                    for (int dt = 0; dt < 2; ++dt) { const LAS unsigned char* vp = Vt + (32 * dt + l32) * VP + (32 * (qt + kk) + 16 * j + 4 * hi) * 2;
                        const u32x2 lo = *(const LAS u32x2*)vp, hh = *(const LAS u32x2*)(vp + 16); const u32x4 vw = (u32x4){lo.x, lo.y, hh.x, hh.y};
                        o[dt] = __builtin_amdgcn_mfma_f32_32x32x16_bf16(__builtin_bit_cast(bf16x8, vw), pb, o[dt], 0, 0, 0); }
                }
            const float inv = 1.0f / lsum;
#pragma unroll
            for (int dt = 0; dt < 2; ++dt)
#pragma unroll
                for (int g4 = 0; g4 < 4; ++g4) { const int d0 = 32 * dt + 8 * g4 + 4 * hi;
                    const u32x2 gw = *(const u32x2*)(proj + qrow * AW + 2560 + h * 64 + d0);
                    u32x2 w; w.x = pk2(o[dt][4 * g4 + 0] * inv * bf_lo(gw.x), o[dt][4 * g4 + 1] * inv * bf_hi(gw.x)); w.y = pk2(o[dt][4 * g4 + 2] * inv * bf_lo(gw.y), o[dt][4 * g4 + 3] * inv * bf_hi(gw.y));
                    *(u32x2*)(z + qrow * DM + h * 64 + d0) = w; }
        }
    }
}

constexpr int XP = 528;
struct L2Args { const bf16* proj; const float *convw, *convb, *ba, *bx, *lam; const bf16 *WA, *WX; unsigned* HA; float *SA, *SH; };
__device__ __forceinline__ void lru2_phase(LAS unsigned char* lds, const L2Args& a, int G, int vb) {
    int tid_ = threadIdx.x; asm volatile("" : "+v"(tid_)); const int tid = tid_, lane = tid & 63, wid = tid >> 6, l32 = lane & 31, hi = lane >> 5;
    LAS unsigned char* XC = lds;
    for (int u = vb; u < 512; u += G) {
        const int hb = u & 7, c = u >> 3;
        __syncthreads();
        {
            const int cg4 = tid & 63, tb = tid >> 6; const int ch = hb * 256 + 4 * cg4;
            const f32x4 w0 = *(const f32x4*)(a.convw + 0 * DM + ch), w1 = *(const f32x4*)(a.convw + 1 * DM + ch), w2 = *(const f32x4*)(a.convw + 2 * DM + ch), w3 = *(const f32x4*)(a.convw + 3 * DM + ch);
            const f32x4 cb = *(const f32x4*)(a.convb + ch);
            const int t0 = c * 128 + 16 * tb;
            f32x4 x0, x1, x2;
            { f32x4 xs[3];
#pragma unroll
              for (int i = 0; i < 3; ++i) { const int t = t0 - 3 + i; u32x2 w = (u32x2){0u, 0u}; if (t >= 0) w = *(const u32x2*)(a.proj + (size_t)t * LW + ch); xs[i] = (f32x4){bf_lo(w.x), bf_hi(w.x), bf_lo(w.y), bf_hi(w.y)}; }
              x0 = xs[0]; x1 = xs[1]; x2 = xs[2]; }
#pragma unroll 8
            for (int o = 0; o < 16; ++o) { const u32x2 w = *(const u32x2*)(a.proj + (size_t)(t0 + o) * LW + ch); const f32x4 x3 = (f32x4){bf_lo(w.x), bf_hi(w.x), bf_lo(w.y), bf_hi(w.y)};
                const f32x4 xc = cb + w0 * x0 + w1 * x1 + w2 * x2 + w3 * x3;
                u32x2 ow; ow.x = pk2(xc.x, xc.y); ow.y = pk2(xc.z, xc.w);
                *(LAS u32x2*)(XC + (16 * tb + o) * XP + cg4 * 8) = ow; x0 = x1; x1 = x2; x2 = x3; }
        }
        const int chl = 32 * wid + l32, ch = hb * 256 + chl;
        bf16x8 wa[16], wx[16];
#pragma unroll
        for (int ks = 0; ks < 16; ++ks) { wa[ks] = *(const bf16x8*)(a.WA + ((size_t)hb * 256 + chl) * 256 + ks * 16 + hi * 8); wx[ks] = *(const bf16x8*)(a.WX + ((size_t)hb * 256 + chl) * 256 + ks * 16 + hi * 8); }
        const float bav = a.ba[ch], bxv = a.bx[ch];
        float nl8; { const float nl = -a.lam[ch]; const float sp = (nl > 20.f) ? nl : log1pf(expf(nl)); nl8 = -8.0f * sp; }
        __syncthreads();
        float Crun = 0.f, Qrun = 1.f;
#pragma unroll 1
        for (int tt = 0; tt < 4; ++tt) {
            unsigned obase = (unsigned)((c * 128 + 32 * tt + 4 * hi) * DM + ch); asm volatile("" : "+v"(obase));
            f32x16 pa = {}, px = {};
#pragma unroll
            for (int ks = 0; ks < 16; ++ks) { const bf16x8 af = *(const LAS bf16x8*)(XC + (32 * tt + l32) * XP + ks * 32 + hi * 16);
                pa = __builtin_amdgcn_mfma_f32_32x32x16_bf16(af, wa[ks], pa, 0, 0, 0); px = __builtin_amdgcn_mfma_f32_32x32x16_bf16(af, wx[ks], px, 0, 0, 0); }
            float hl[16], pl[16], P[4], H[4];
#pragma unroll
            for (int g = 0; g < 4; ++g) { float p = 1.f, hh = 0.f;
#pragma unroll
                for (int j = 0; j < 4; ++j) { const int r = 4 * g + j; const int tok = 32 * tt + crow(r, hi);
                    const float rg = sigmoid_f(pa[r] + bav), ig = sigmoid_f(px[r] + bxv);
                    const float la = rg * nl8; const float av = __builtin_amdgcn_exp2f(la * LOG2E);
                    const float x2 = 2.0f * la;
                    const float poly = -x2 * (1.0f + x2 * (0.5f + x2 * (0.16666667f + x2 * (0.041666668f + x2 * (0.0083333338f + x2 * (0.0013888889f + x2 * 0.0001984127f))))));
                    const float em1 = (x2 > -0.3f) ? poly : (1.0f - av * av);
                    const float xcv = __uint_as_float((unsigned)(*(const LAS unsigned short*)(XC + tok * XP + chl * 2)) << 16);
                    const float bv = sqrtf(em1) * ig * xcv;
                    hh = av * hh + bv; p *= av; hl[r] = hh; pl[r] = p; }
                P[g] = p; H[g] = hh; }
            float Po[4], Ho[4];
#pragma unroll
            for (int g = 0; g < 4; ++g) { Po[g] = __shfl_xor(P[g], 32); Ho[g] = __shfl_xor(H[g], 32); }
            float cc = Crun, qq = Qrun;
#pragma unroll
            for (int g = 0; g < 4; ++g) {
                const float P0 = hi ? Po[g] : P[g], H0 = hi ? Ho[g] : H[g], P1 = hi ? P[g] : Po[g], H1 = hi ? H[g] : Ho[g];
                const float c0 = cc, q0 = qq; cc = P0 * cc + H0; qq = qq * P0;
                const float c1 = cc, q1 = qq; cc = P1 * cc + H1; qq = qq * P1;
                const float cm = hi ? c1 : c0, qm = hi ? q1 : q0;
#pragma unroll
                for (int j = 0; j < 4; ++j) { const int r = 4 * g + j; a.HA[obase + (unsigned)((8 * g + j) * DM)] = pk2(hl[r] + pl[r] * cm, pl[r] * qm); }
            }
            Crun = cc; Qrun = qq;
        }
        if (hi == 0) { a.SA[(size_t)c * DM + ch] = Qrun; a.SH[(size_t)c * DM + ch] = Crun; }
    }
}
__device__ __forceinline__ void lru3_phase(const unsigned* HA, const float* SA, const float* SH, const bf16* proj, bf16* z, int G, int vb) {
    int tid_ = threadIdx.x; asm volatile("" : "+v"(tid_)); const int tid = tid_; const int ch = 4 * tid;
    for (int u = vb; u < 512; u += G) {
        const int c = u >> 3, sub = u & 7;
        f32x4 carry = (f32x4){0.f, 0.f, 0.f, 0.f};
        for (int cp = 0; cp < c; ++cp) { const f32x4 A = *(const f32x4*)(SA + (size_t)cp * DM + ch), H = *(const f32x4*)(SH + (size_t)cp * DM + ch); carry = A * carry + H; }
#pragma unroll 4
        for (int i = 0; i < 16; ++i) { const size_t t = (size_t)(c * 128 + sub * 16 + i);
            const u32x4 hw = *(const u32x4*)(HA + t * DM + ch); const u32x2 gw = *(const u32x2*)(proj + t * LW + 2048 + ch);
            const float h0 = (bf_lo(hw.x) + bf_hi(hw.x) * carry.x) * bf_lo(gw.x), h1 = (bf_lo(hw.y) + bf_hi(hw.y) * carry.y) * bf_hi(gw.x);
            const float h2 = (bf_lo(hw.z) + bf_hi(hw.z) * carry.z) * bf_lo(gw.y), h3 = (bf_lo(hw.w) + bf_hi(hw.w) * carry.w) * bf_hi(gw.y);
            u32x2 w; w.x = pk2(h0, h1); w.y = pk2(h2, h3); *(u32x2*)(z + t * DM + ch) = w; }
    }
}

#define XB_TMO      128
#define XB_XCNT(j)  (256  + 64 * (j))
#define XB_XSUB(j)  (1280 + 64 * (j))
#define XB_XGEN(j)  (2304 + 64 * (j))
#define XB_TOP      3328
#define XB_TOPGEN   3392
#define XCD_BAR_WORDS 3456
#define XB_SPIN_CAP (1u << 18)

__device__ __forceinline__ unsigned xb_ld(unsigned* p)              { return __hip_atomic_load(p, __ATOMIC_RELAXED, __HIP_MEMORY_SCOPE_AGENT); }
__device__ __forceinline__ unsigned xb_add(unsigned* p, unsigned v) { return __hip_atomic_fetch_add(p, v, __ATOMIC_RELAXED, __HIP_MEMORY_SCOPE_AGENT); }
__device__ __forceinline__ unsigned xb_xcc_id() { return (unsigned)__builtin_amdgcn_s_getreg((3 << 11) | 20) & 0xFu; }
#define XB_SPIN(cond, bar) do { unsigned _sp = 0; while (cond) { __builtin_amdgcn_s_sleep(1); \
    if ((++_sp & 255u) == 0u) { if (xb_ld(&(bar)[XB_TMO])) break; if (_sp > XB_SPIN_CAP) { atomicAdd(&(bar)[XB_TMO], 1u); break; } } } } while (0)

struct XcdBarrier {
    unsigned* bar; unsigned x;
    volatile LAS unsigned* st;
};

__device__ __forceinline__ XcdBarrier xcd_barrier_post(unsigned* bar, volatile LAS unsigned* st) {
    XcdBarrier b; b.bar = bar; b.x = xb_xcc_id(); b.st = st;
    if (threadIdx.x == 0) (void)xb_add(&bar[XB_XCNT(b.x)], 1u);
    return b;
}
__device__ __forceinline__ void xcd_barrier_complete(unsigned* bar, unsigned x, unsigned& nloc, unsigned& nx) {
    const unsigned G = gridDim.x * gridDim.y * gridDim.z;
    unsigned sum, cnt, mine, sp = 0u;
    for (;;) {
        sum = 0u; cnt = 0u; mine = 0u;
#pragma unroll
        for (unsigned j = 0; j < 16; ++j) { const unsigned c = xb_ld(&bar[XB_XCNT(j)]); sum += c; cnt += (c > 0u) ? 1u : 0u; mine = (j == x) ? c : mine; }
        if (sum == G) break;
        __builtin_amdgcn_s_sleep(1);
        if ((++sp & 255u) == 0u) { if (xb_ld(&bar[XB_TMO])) break; if (sp > XB_SPIN_CAP) { atomicAdd(&bar[XB_TMO], 1u); break; } }
    }
    nloc = mine > 0u ? mine : 1u; nx = cnt > 0u ? cnt : 1u;
}

__device__ __forceinline__ void xcd_barrier(const XcdBarrier& b) {
    asm volatile("s_waitcnt vmcnt(0)" ::: "memory");
    __syncthreads();
    if (threadIdx.x == 0) {
        unsigned* bar = b.bar;
        __builtin_amdgcn_s_waitcnt(0);
        unsigned nloc = b.st[0], nx = b.st[1];
        if (nloc == 0u) { xcd_barrier_complete(bar, b.x, nloc, nx); b.st[0] = nloc; b.st[1] = nx; }
        const unsigned old = xb_add(&bar[XB_XSUB(b.x)], 1u);
        const unsigned gen = old / nloc;
        if (old + 1u == (gen + 1u) * nloc) {
            __builtin_amdgcn_fence(__ATOMIC_RELEASE, "agent");
            asm volatile("s_waitcnt vmcnt(0)" ::: "memory");
            const unsigned og = xb_add(&bar[XB_TOP], 1u);
            const unsigned tg = og / nx;
            if (og + 1u == (tg + 1u) * nx) xb_add(&bar[XB_TOPGEN], 1u);
            else XB_SPIN(xb_ld(&bar[XB_TOPGEN]) == tg, bar);
            __builtin_amdgcn_fence(__ATOMIC_ACQUIRE, "agent");
            xb_add(&bar[XB_XGEN(b.x)], 1u);
            asm volatile("s_waitcnt vmcnt(0)" ::: "memory");
        } else {
            XB_SPIN(xb_ld(&bar[XB_XGEN(b.x)]) == gen, bar);
            __builtin_amdgcn_fence(__ATOMIC_ACQUIRE, "agent");
            asm volatile("s_waitcnt vmcnt(0)" ::: "memory");
        }
    }
    __syncthreads();
}

struct Args { const float* in[15]; float* out; unsigned char* ws; int ph_lo, ph_hi; };
constexpr int N_PHASES = 19;
__global__ void __launch_bounds__(512, 2) mk_fwd(Args args) {
    extern __shared__ __attribute__((aligned(16))) unsigned char lds_raw[];
    LAS unsigned char* lds = (LAS unsigned char*)lds_raw;
    cg::grid_group grid = cg::this_grid();
    if (threadIdx.x < 64) ((LAS unsigned*)(lds + LDSCTL_OFF))[threadIdx.x] = 0u;
    __syncthreads();
    XcdBarrier bar = xcd_barrier_post((unsigned*)(args.ws + WS_CTL), (volatile LAS unsigned*)(lds + LDSCTL_OFF));
    const int G = gridDim.x, bx = blockIdx.x;
    const int lo = args.ph_lo, hi = args.ph_hi;
    unsigned char* ws = args.ws;
    const float* x = args.in[0]; const float* npre = args.in[1]; const float* npost = args.in[2];
    const float* awin = args.in[3]; const float* awout = args.in[4]; const float* sinks = args.in[5];
    const float* lwin = args.in[6]; const float* convw = args.in[7]; const float* convb = args.in[8];
    const float* wa = args.in[9]; const float* ba = args.in[10]; const float* wx = args.in[11]; const float* bxp = args.in[12];
    const float* lam = args.in[13]; const float* lwout = args.in[14];
    float* out = args.out;
    bf16* WAIN = (bf16*)(ws + WS_WAIN); bf16* WAOUT = (bf16*)(ws + WS_WAOUT); bf16* WLIN = (bf16*)(ws + WS_WLIN); bf16* WLOUT = (bf16*)(ws + WS_WLOUT);
    bf16* WA = (bf16*)(ws + WS_WA); bf16* WX = (bf16*)(ws + WS_WX); bf16* UZ = (bf16*)(ws + WS_UZ); bf16* PROJ = (bf16*)(ws + WS_PROJ);
    float* Y = (float*)(ws + WS_Y); unsigned* HA = (unsigned*)(ws + WS_Y);
    float* SA = (float*)(ws + WS_SUM); float* SH = SA + 64 * DM;
#pragma unroll 1
    for (int ph = lo; ph < hi; ++ph) {
        const int q = ph - 1, j = q / 9, k = q - 9 * j;
        if (ph == 0) { P0Args pa{x, npre, awin, awout, lwin, lwout, wa, wx, WAIN, WAOUT, WLIN, WLOUT, WA, WX, UZ}; if (!SKIP_P0) p0_phase(lds, pa, G, bx); }
        else if (k == 0 || k == 2 || k == 4 || k == 7) {
            const bf16* Bt = (k == 0) ? WAIN + (size_t)j * DM * AW : (k == 2) ? WAOUT + (size_t)j * DM * DM : (k == 4) ? WLIN + (size_t)j * DM * LW : WLOUT + (size_t)j * DM * DM;
            const int N = (k == 0) ? AW : (k == 4) ? LW : DM;
            pg8::Gemm g{UZ, Bt, S, N, DM}; pg8::StaticOrder so; so.init(S, N, G, bx);
            pg8::EpiAny E; E.f32out = (k == 2 || k == 7); E.O = E.f32out ? (void*)Y : (void*)PROJ; E.ldc = N; E.q_tiles = (k == 0) ? 8 : 0; E.qscale = QSCALE; E.silu_from = (k == 0) ? 10 : 8;
            if (!SKIP_G1) pg8::gemm_phase<pg8::EpiAny, pg8::StaticOrder, true, true>(lds, g, so, E);
        }
        else if (k == 1) { if (!SKIP_ATT) attn_phase(lds, PROJ, sinks + j * NHEAD, UZ, G, bx); }
        else if (k == 3 || k == 8) { const int layer = 2 * j + (k == 8);
            if (!SKIP_NORM) norm_phase(Y, layer == 0 ? x : out, out, npost + (size_t)layer * DM, layer < 3 ? npre + (size_t)(layer + 1) * DM : nullptr, UZ, G, bx); }
        else if (k == 5) { L2Args la{PROJ, convw + (size_t)j * 4 * DM, convb + (size_t)j * DM, ba + (size_t)j * DM, bxp + (size_t)j * DM, lam + (size_t)j * DM,
                                     WA + (size_t)j * 8 * 65536, WX + (size_t)j * 8 * 65536, HA, SA, SH}; if (!SKIP_L2) lru2_phase(lds, la, G, bx); }
        else if (!SKIP_L3) lru3_phase(HA, SA, SH, PROJ, UZ, G, bx);
        if (ph + 1 < hi) { if (ph == 0) grid.sync(); else xcd_barrier(bar); }
    }
}

extern "C" void kernel_launch(void* const* d_in, const int* in_sizes, int n_in, void* d_out, int out_size, void* d_ws, size_t ws_size, hipStream_t stream) {
    static int grid = 0;
    if (grid == 0) {
        if (n_in != 15 || out_size != S * DM || ws_size < WS_END) { fprintf(stderr, "kernel_launch: unexpected shapes (n_in %d out %d ws %zu)\n", n_in, out_size, ws_size); grid = -1; return; }
        int dev = 0, cus = 0, per_cu = 0;
        (void)hipGetDevice(&dev); (void)hipDeviceGetAttribute(&cus, hipDeviceAttributeMultiprocessorCount, dev);
        (void)hipFuncSetAttribute((const void*)mk_fwd, hipFuncAttributeMaxDynamicSharedMemorySize, LDS_BYTES);
        if (hipOccupancyMaxActiveBlocksPerMultiprocessor(&per_cu, (const void*)mk_fwd, 512, LDS_BYTES) != hipSuccess || per_cu < 1) per_cu = 1;
        (void)hipGetLastError();
        grid = cus * per_cu; if (grid <= 0) grid = 256;
    }
    if (grid < 0) return;
    Args a{};
    for (int i = 0; i < 15; ++i) a.in[i] = (const float*)d_in[i];
    a.out = (float*)d_out; a.ws = (unsigned char*)d_ws;
    (void)hipMemsetAsync((char*)d_ws + WS_CTL, 0, CTL_ZERO_BYTES, stream);
#if MK_N_LAUNCHES == 1
    a.ph_lo = 0; a.ph_hi = N_PHASES;
    void* kargs[] = {&a};
    hipError_t e = hipLaunchCooperativeKernel((const void*)mk_fwd, dim3(grid), dim3(512), kargs, LDS_BYTES, stream);
    if (e != hipSuccess) fprintf(stderr, "cooperative launch failed: %s (grid %d)\n", hipGetErrorString(e), grid);
#else
    for (int ph = 0; ph < N_PHASES; ++ph) { a.ph_lo = ph; a.ph_hi = ph + 1; hipLaunchKernelGGL(mk_fwd, dim3(grid), dim3(512), LDS_BYTES, stream, a); }
#endif
}
```
